# Optimizing an MI355X kernel written in HIP

```python
import jax, jax.numpy as jnp
from jax import lax
import numpy as np

D_MODEL = 1024
BATCH = 1
SEQ = 16384
DEPTH = 2
DEC_BATCH = 2
DEC_SEQ = 16384
PAST_LEN = 128

GRID_W = 64
BLOCK = 128
HEAD_DIM = 64
A_HEADS = 8
A_KV_HEADS = 2
B_HEADS = 8
B_KV_HEADS = 2
WINDOW = 128
IN_COLS = (A_HEADS + 2 * A_KV_HEADS + B_HEADS + 2 * B_KV_HEADS) * HEAD_DIM
MIX_WIDTH = (A_HEADS + B_HEADS) * HEAD_DIM
C_HEADS = 16
Q_LORA = 384
KV_LORA = 256
NOPE_DIM = 64
ROPE_DIM = 32
V_DIM = 64
C_DOWN_COLS = Q_LORA + KV_LORA + ROPE_DIM
D_FF = 2816
CONV_W = 3
ROPE_THETA = 10000.0
EPS = 1e-6
N_EVEN = (DEPTH + 1) // 2
N_ODD = DEPTH // 2

kernel_name = 'hybrid_axial_window_mla_encoder'


def _rms_norm(x, g):
    xf = x.astype(jnp.float32)
    y = xf * lax.rsqrt(jnp.mean(xf * xf, axis=-1, keepdims=True) + EPS)
    return (y * g.astype(jnp.float32)).astype(x.dtype)


def _rope_angles(pos, dim):
    inv_freq = ROPE_THETA ** (-jnp.arange(0, dim, 2, dtype=jnp.float32) / dim)
    ang = pos.astype(jnp.float32)[:, None] * inv_freq[None, :]
    return jnp.cos(ang), jnp.sin(ang)


def _apply_rope(x, cos, sin):
    xf = x.astype(jnp.float32)
    x1, x2 = jnp.split(xf, 2, axis=-1)
    c = cos[:, None, :]
    sn = sin[:, None, :]
    return jnp.concatenate([x1 * c - x2 * sn, x2 * c + x1 * sn], axis=-1).astype(x.dtype)


def _axial_rope(x, cos_r, sin_r, cos_c, sin_c):
    half = x.shape[-1] // 2
    return jnp.concatenate([_apply_rope(x[..., :half], cos_r, sin_r),
                            _apply_rope(x[..., half:], cos_c, sin_c)], axis=-1)


def _dense_attention(q, k, v, scale):
    b, s, hq, dk = q.shape
    hkv = k.shape[2]
    g = hq // hkv
    dv = v.shape[-1]
    nblk = s // BLOCK
    qb = jnp.moveaxis(q.reshape(b, nblk, BLOCK, hkv, g, dk), 1, 0)

    def one_block(qi):
        sc = jnp.einsum('bqkgd,bskd->bkgqs', qi, k, preferred_element_type=jnp.float32) * scale
        p = jax.nn.softmax(sc, axis=-1)
        return jnp.einsum('bkgqs,bskd->bqkgd', p.astype(v.dtype), v)

    o = lax.map(one_block, qb)
    return jnp.moveaxis(o, 0, 1).reshape(b, s, hq, dv)


def _window_sink_attention(q, k, v, sink, slopes):
    b, s, hq, d = q.shape
    hkv = k.shape[2]
    g = hq // hkv
    nblk = s // BLOCK
    qb = q.reshape(b, nblk, BLOCK, hkv, g, d)

    def band(z):
        zp = jnp.pad(z, ((0, 0), (BLOCK, BLOCK), (0, 0), (0, 0)))
        zp = zp.reshape(b, nblk + 2, BLOCK, z.shape[2], z.shape[3])
        return jnp.concatenate([zp[:, :-2], zp[:, 1:-1], zp[:, 2:]], axis=2)

    kb = band(k)
    vb = band(v)
    sc = jnp.einsum('bnqkgd,bnskd->bnkgqs', qb, kb, preferred_element_type=jnp.float32) * (d ** -0.5)
    dist = jnp.abs(jnp.arange(3 * BLOCK)[None, :] - BLOCK - jnp.arange(BLOCK)[:, None])
    kpos = (jnp.arange(nblk)[:, None] - 1) * BLOCK + jnp.arange(3 * BLOCK)[None, :]
    valid = (dist <= WINDOW)[None] & ((kpos >= 0) & (kpos < s))[:, None, :]
    bias = -slopes.reshape(hkv, g)[:, :, None, None] * dist.astype(jnp.float32)
    sc = jnp.where(valid[None, :, None, None], sc + bias, -jnp.inf)
    sink_l = sink.astype(jnp.float32).reshape(1, 1, hkv, g, 1, 1)
    m = jnp.maximum(jnp.max(sc, axis=-1, keepdims=True), sink_l)
    e = jnp.exp(sc - m)
    p = e / (jnp.sum(e, axis=-1, keepdims=True) + jnp.exp(sink_l - m))
    o = jnp.einsum('bnkgqs,bnskd->bnqkgd', p.astype(v.dtype), vb)
    return o.reshape(b, s, hq, d)


def _even_mixer(h, w_in, q_gain, k_gain, sink, w_out, axial, slopes):
    b, s, _ = h.shape
    sizes = [A_HEADS * HEAD_DIM, A_KV_HEADS * HEAD_DIM, A_KV_HEADS * HEAD_DIM,
             B_HEADS * HEAD_DIM, B_KV_HEADS * HEAD_DIM, B_KV_HEADS * HEAD_DIM]
    cuts = [int(c) for c in np.cumsum(sizes)[:-1]]
    qa, ka, va, qb, kb, vb = jnp.split(h @ w_in, cuts, axis=-1)
    qa = _axial_rope(_rms_norm(qa.reshape(b, s, A_HEADS, HEAD_DIM), q_gain), *axial)
    ka = _axial_rope(_rms_norm(ka.reshape(b, s, A_KV_HEADS, HEAD_DIM), k_gain), *axial)
    va = va.reshape(b, s, A_KV_HEADS, HEAD_DIM)
    oa = _dense_attention(qa, ka, va, HEAD_DIM ** -0.5)
    qb = qb.reshape(b, s, B_HEADS, HEAD_DIM)
    kb = kb.reshape(b, s, B_KV_HEADS, HEAD_DIM)
    vb = vb.reshape(b, s, B_KV_HEADS, HEAD_DIM)
    ob = _window_sink_attention(qb, kb, vb, sink, slopes)
    o = jnp.concatenate([oa.reshape(b, s, A_HEADS * HEAD_DIM), ob.reshape(b, s, B_HEADS * HEAD_DIM)], axis=-1)
    return o @ w_out


def _mla(h, w_down, q_gain, kv_gain, w_uq, w_ukv, w_out, cos, sin):
    b, s, _ = h.shape
    cq, ckv, k_rope = jnp.split(h @ w_down, [Q_LORA, Q_LORA + KV_LORA], axis=-1)
    q = (_rms_norm(cq, q_gain) @ w_uq).reshape(b, s, C_HEADS, NOPE_DIM + ROPE_DIM)
    q_nope, q_rope = jnp.split(q, [NOPE_DIM], axis=-1)
    kv = (_rms_norm(ckv, kv_gain) @ w_ukv).reshape(b, s, C_HEADS, NOPE_DIM + V_DIM)
    k_nope, v = jnp.split(kv, [NOPE_DIM], axis=-1)
    k_rope = _apply_rope(k_rope[:, :, None, :], cos, sin)
    q = jnp.concatenate([q_nope, _apply_rope(q_rope, cos, sin)], axis=-1)
    k = jnp.concatenate([k_nope, jnp.broadcast_to(k_rope, (b, s, C_HEADS, ROPE_DIM))], axis=-1)
    o = _dense_attention(q, k, v, (NOPE_DIM + ROPE_DIM) ** -0.5)
    return o.reshape(b, s, C_HEADS * V_DIM) @ w_out


def _conv_glu(h, w_up, conv_w, conv_b, w_down):
    s = h.shape[1]
    gate, val = jnp.split(h @ w_up, 2, axis=-1)
    pad = CONV_W // 2
    gp = jnp.pad(gate, ((0, 0), (pad, pad), (0, 0)))
    gc = conv_b
    for j in range(CONV_W):
        gc = gc + gp[:, j:j + s] * conv_w[j]
    return (jax.nn.silu(gc) * val) @ w_down


def _trunk(x, norm_mix, norm_ffn, norm_final, e_w_in, e_q_gain, e_k_gain, e_sink, e_w_out,
           o_w_down, o_q_gain, o_kv_gain, o_w_uq, o_w_ukv, o_w_out,
           f_w_up, f_conv_w, f_conv_b, f_w_down):
    s = x.shape[1]
    rows = s // GRID_W
    row = jnp.repeat(jnp.arange(rows), GRID_W)
    col = jnp.tile(jnp.arange(GRID_W), rows)
    cos_r, sin_r = _rope_angles(row, HEAD_DIM // 2)
    cos_c, sin_c = _rope_angles(col, HEAD_DIM // 2)
    axial = (cos_r, sin_r, cos_c, sin_c)
    cos_t, sin_t = _rope_angles(jnp.arange(s), ROPE_DIM)
    slopes = 2.0 ** (-8.0 * jnp.arange(1, B_HEADS + 1, dtype=jnp.float32) / B_HEADS)
    for l in range(DEPTH):
        h = _rms_norm(x, norm_mix[l])
        if l % 2 == 0:
            i = l // 2
            x = x + _even_mixer(h, e_w_in[i], e_q_gain[i], e_k_gain[i], e_sink[i], e_w_out[i], axial, slopes)
        else:
            i = l // 2
            x = x + _mla(h, o_w_down[i], o_q_gain[i], o_kv_gain[i], o_w_uq[i], o_w_ukv[i], o_w_out[i], cos_t, sin_t)
        h = _rms_norm(x, norm_ffn[l])
        x = x + _conv_glu(h, f_w_up[l], f_conv_w[l], f_conv_b[l], f_w_down[l])
    return _rms_norm(x, norm_final)


def setup_inputs(seed: int = 0) -> dict:
    key = jax.random.key(seed)
    ks = jax.random.split(key, 20)
    f32 = jnp.float32

    def w(k, shape, fan_in):
        return jax.random.normal(k, shape, f32) * (fan_in ** -0.5)

    def gain(k, shape):
        return 1.0 + 0.02 * jax.random.normal(k, shape, f32)

    return {
        'x_prompt': jax.random.normal(ks[0], (BATCH, SEQ, D_MODEL), f32),
        'x_sample': jax.random.normal(ks[1], (DEC_BATCH, DEC_SEQ, D_MODEL), f32),
        'norm_mix': gain(ks[2], (DEPTH, D_MODEL)),
        'norm_ffn': gain(ks[3], (DEPTH, D_MODEL)),
        'norm_final': gain(ks[4], (D_MODEL,)),
        'e_w_in': w(ks[5], (N_EVEN, D_MODEL, IN_COLS), D_MODEL),
        'e_q_gain': gain(ks[6], (N_EVEN, HEAD_DIM)),
        'e_k_gain': gain(ks[7], (N_EVEN, HEAD_DIM)),
        'e_sink': 0.5 * jax.random.normal(ks[8], (N_EVEN, B_HEADS), f32),
        'e_w_out': w(ks[9], (N_EVEN, MIX_WIDTH, D_MODEL), MIX_WIDTH),
        'o_w_down': w(ks[10], (N_ODD, D_MODEL, C_DOWN_COLS), D_MODEL),
        'o_q_gain': gain(ks[11], (N_ODD, Q_LORA)),
        'o_kv_gain': gain(ks[12], (N_ODD, KV_LORA)),
        'o_w_uq': w(ks[13], (N_ODD, Q_LORA, C_HEADS * (NOPE_DIM + ROPE_DIM)), Q_LORA),
        'o_w_ukv': w(ks[14], (N_ODD, KV_LORA, C_HEADS * (NOPE_DIM + V_DIM)), KV_LORA),
        'o_w_out': w(ks[15], (N_ODD, C_HEADS * V_DIM, D_MODEL), C_HEADS * V_DIM),
        'f_w_up': w(ks[16], (DEPTH, D_MODEL, 2 * D_FF), D_MODEL),
        'f_conv_w': w(ks[17], (DEPTH, CONV_W, D_FF), CONV_W),
        'f_conv_b': 0.01 * jax.random.normal(ks[18], (DEPTH, D_FF), f32),
        'f_w_down': w(ks[19], (DEPTH, D_FF, D_MODEL), D_FF),
    }


def reference(x_prompt, x_sample, norm_mix, norm_ffn, norm_final, e_w_in, e_q_gain, e_k_gain, e_sink,
              e_w_out, o_w_down, o_q_gain, o_kv_gain, o_w_uq, o_w_ukv, o_w_out,
              f_w_up, f_conv_w, f_conv_b, f_w_down):
    y_prompt = _trunk(x_prompt, norm_mix, norm_ffn, norm_final, e_w_in, e_q_gain, e_k_gain, e_sink, e_w_out,
                      o_w_down, o_q_gain, o_kv_gain, o_w_uq, o_w_ukv, o_w_out,
                      f_w_up, f_conv_w, f_conv_b, f_w_down)
    y_sample = _trunk(x_sample, norm_mix, norm_ffn, norm_final, e_w_in, e_q_gain, e_k_gain, e_sink, e_w_out,
                      o_w_down, o_q_gain, o_kv_gain, o_w_uq, o_w_ukv, o_w_out,
                      f_w_up, f_conv_w, f_conv_b, f_w_down)
    return (y_prompt, y_sample)
```

```cpp
#include <hip/hip_runtime.h>
#include <hip/hip_cooperative_groups.h>
#include <cstdio>
#include <cstdint>
namespace cg = cooperative_groups;

namespace pg8 {
#define PG8_LAS __attribute__((address_space(3)))
typedef unsigned short bf16_t;
typedef short bf16x8 __attribute__((ext_vector_type(8)));
typedef float f32x4 __attribute__((ext_vector_type(4)));
typedef unsigned u32x4 __attribute__((ext_vector_type(4)));
constexpr int BM = 256, BK = 64, HALF = 128, HTB = HALF * BK * 2  , STAGE_BYTES = 8 * HTB, NXCD = 8, WGM = 8;

__host__ __device__ __forceinline__ int lds_byte(int r, int c) { const int st = (r >> 4) * 2 + (c >> 5), rr = r & 15, cc = c & 31, ob = rr * 64 + cc * 2; return st * 1024 + (ob ^ (((ob >> 9) & 1) << 5)); }
__host__ __device__ __forceinline__ void stage_rc(int b, int& R, int& C) { const int st = b / 1024, sb = b % 1024, swz = sb ^ (((sb >> 9) & 1) << 5); R = (st >> 1) * 16 + swz / 64; C = (st & 1) * 32 + (swz % 64) / 2; }
__host__ __device__ __forceinline__ int perm32(int rho) { const int n = rho >> 4, i = rho & 15; return 8 * (i >> 2) + 4 * n + (i & 3); }

struct Unit { int pm, pn; };
struct Gemm { const bf16_t* A; const bf16_t* Bt; int M, N, K; };

struct StaticOrder {
    int nM, nN, nwg, G, c;
    __host__ __device__ void init_t(int nM_, int nN_, int G_, int c_) { nM = nM_; nN = nN_; nwg = nM * nN; G = G_; c = c_; }
    __host__ __device__ void init(int M, int N, int G_, int c_) { init_t(M / BM, N / BM, G_, c_); }
    __host__ __device__ bool next(int i, Unit& u) const {
        const long L = (long)i * G + c; if (L >= nwg) return false;
        int wgid = (int)L; { const int q = nwg / NXCD, r = nwg % NXCD, xcd = wgid % NXCD, off = wgid / NXCD; wgid = (xcd < r ? xcd * (q + 1) : r * (q + 1) + (xcd - r) * q) + off; }
        const int nig = WGM * nN, gid = wgid / nig, fm = gid * WGM, gsz = (nM - fm) < WGM ? (nM - fm) : WGM;
        u.pm = fm + ((wgid % nig) % gsz); u.pn = (wgid % nig) / gsz; return true;
    }
    __device__ __forceinline__ void a_ready(const Unit&) const {}
    __device__ __forceinline__ void done(const Unit&) const {}
};

__device__ __forceinline__ unsigned cvt_pk_bf16(float lo, float hi) { unsigned r; asm volatile("v_cvt_pk_bf16_f32 %0, %1, %2" : "=v"(r) : "v"(lo), "v"(hi)); return r; }

struct EpiBf16 {
    static constexpr bool PERM = true, AFTER_DRAIN = false, HALO = false;
    bf16_t* O; int ldc; int split_cols; size_t split_stride;
    const float* rowss;
    __device__ __forceinline__ long a_row(int pm) const { return (long)pm * BM; }
    __device__ __forceinline__ void operator()(const f32x4 (&acc)[2][2][4][2], const Unit& u, int wr, int wc, int fr, int fq) const {
        int colt = u.pn * BM; bf16_t* base = O; if (split_cols) { const int t = colt / split_cols; base += (size_t)t * split_stride; colt -= t * split_cols; }
        const int row0 = u.pm * BM + wr * 64 + fr; const int col0 = colt + wc * 32 + 8 * fq;
#pragma unroll
        for (int ai = 0; ai < 2; ++ai)
#pragma unroll
            for (int m = 0; m < 4; ++m) { bf16_t* rowp = base + (size_t)(row0 + ai * HALF + m * 16) * ldc + col0;
                const float rs = rowss ? __builtin_amdgcn_rsqf(rowss[row0 + ai * HALF + m * 16] * (1.0f / 1024.0f) + 1e-6f) : 1.0f;
#pragma unroll
                for (int bj = 0; bj < 2; ++bj) { const f32x4 v0 = acc[ai][bj][m][0] * rs, v1 = acc[ai][bj][m][1] * rs;
                    u32x4 w; w.x = cvt_pk_bf16(v0[0], v0[1]); w.y = cvt_pk_bf16(v0[2], v0[3]); w.z = cvt_pk_bf16(v1[0], v1[1]); w.w = cvt_pk_bf16(v1[2], v1[3]);
                    *(u32x4*)(rowp + bj * HALF) = w; } }
    }
};
template <bool BASEB> struct EpiResT {
    static constexpr bool PERM = true, AFTER_DRAIN = false, HALO = false;
    const float* base0; const float* base1; int split; const bf16_t* baseb; float* out; int ldc; bf16_t* hb; float* rowss;
    __device__ __forceinline__ long a_row(int pm) const { return (long)pm * BM; }
    __device__ __forceinline__ void operator()(const f32x4 (&acc)[2][2][4][2], const Unit& u, int wr, int wc, int fr, int fq) const {
        const int row0 = u.pm * BM + wr * 64 + fr; const int col0 = u.pn * BM + wc * 32 + 8 * fq;
        constexpr int NB = BASEB ? 4 : 2;
#pragma unroll
        for (int ai = 0; ai < 2; ++ai)
#pragma unroll
            for (int mb = 0; mb < 4; mb += NB) {
                f32x4 b0[NB][2], b1[NB][2];
                if (BASEB) { u32x4 w[NB][2];
#pragma unroll
                    for (int q = 0; q < NB; ++q)
#pragma unroll
                        for (int bj = 0; bj < 2; ++bj) w[q][bj] = *(const u32x4*)(baseb + (size_t)(row0 + ai * HALF + (mb + q) * 16) * ldc + col0 + bj * HALF);
#pragma unroll
                    for (int q = 0; q < NB; ++q)
#pragma unroll
                        for (int bj = 0; bj < 2; ++bj) { const u32x4 v = w[q][bj];
                            b0[q][bj] = (f32x4){__uint_as_float(v.x << 16), __uint_as_float(v.x & 0xffff0000u), __uint_as_float(v.y << 16), __uint_as_float(v.y & 0xffff0000u)};
                            b1[q][bj] = (f32x4){__uint_as_float(v.z << 16), __uint_as_float(v.z & 0xffff0000u), __uint_as_float(v.w << 16), __uint_as_float(v.w & 0xffff0000u)}; }
                } else {
#pragma unroll
                    for (int q = 0; q < NB; ++q) { const int row = row0 + ai * HALF + (mb + q) * 16;
                        const float* bp = (row < split ? base0 + (size_t)row * ldc : base1 + (size_t)(row - split) * ldc) + col0;
#pragma unroll
                        for (int bj = 0; bj < 2; ++bj) { b0[q][bj] = *(const f32x4*)(bp + bj * HALF); b1[q][bj] = *(const f32x4*)(bp + bj * HALF + 4); } }
                }
#pragma unroll
                for (int q = 0; q < NB; ++q) { const int m = mb + q; const int row = row0 + ai * HALF + m * 16;
                    float ss = 0.f;
#pragma unroll
                    for (int bj = 0; bj < 2; ++bj) {
                        const f32x4 x0 = acc[ai][bj][m][0] + b0[q][bj], x1 = acc[ai][bj][m][1] + b1[q][bj];
                        if (out) { float* op = out + (size_t)row * ldc + col0 + bj * HALF; *(f32x4*)op = x0; *(f32x4*)(op + 4) = x1; }
                        if (hb) { ss += (x0[0] * x0[0] + x0[1] * x0[1]) + (x0[2] * x0[2] + x0[3] * x0[3]) + (x1[0] * x1[0] + x1[1] * x1[1]) + (x1[2] * x1[2] + x1[3] * x1[3]);
                            u32x4 w; w.x = cvt_pk_bf16(x0[0], x0[1]); w.y = cvt_pk_bf16(x0[2], x0[3]); w.z = cvt_pk_bf16(x1[0], x1[1]); w.w = cvt_pk_bf16(x1[2], x1[3]);
                            *(u32x4*)(hb + (size_t)row * ldc + col0 + bj * HALF) = w; } }
                    if (hb) { ss += __shfl_xor(ss, 16); ss += __shfl_xor(ss, 32); if (fq == 0) atomicAdd(rowss + row, ss); } }
            }
    }
};
__device__ __forceinline__ float dpp_ror1(float v)  { return __builtin_bit_cast(float, __builtin_amdgcn_mov_dpp(__builtin_bit_cast(int, v), 0x121, 0xf, 0xf, true)); }
__device__ __forceinline__ float dpp_ror15(float v) { return __builtin_bit_cast(float, __builtin_amdgcn_mov_dpp(__builtin_bit_cast(int, v), 0x12F, 0xf, 0xf, true)); }
struct EpiGlu {
    static constexpr bool PERM = true, AFTER_DRAIN = false, HALO = true;
    static constexpr int SEQ = 16384, TPS = 67  , FF = 2816;
    bf16_t* O; const float* cw; const float* cb; const float* rowss;
    __device__ __forceinline__ long a_row(int pm) const { const int sq = pm / TPS, tl = pm % TPS; return (long)sq * SEQ + 248 * tl - 1; }
    __device__ __forceinline__ void operator()(const f32x4 (&acc)[2][2][4][2], const Unit& u, int wr, int wc, int fr, int fq) const {
        const int sq = u.pm / TPS, tl = u.pm % TPS; const int f0 = u.pn * 128 + wc * 32 + 8 * fq;
        float w0[8], w1[8], w2[8], bb[8];
#pragma unroll
        for (int j = 0; j < 8; ++j) { constexpr float NL = -1.4426950408889634f;
            w0[j] = NL * cw[f0 + j]; w1[j] = NL * cw[FF + f0 + j]; w2[j] = NL * cw[2 * FF + f0 + j]; bb[j] = NL * cb[f0 + j]; }
        float rsa[2][4];
#pragma unroll
        for (int ai = 0; ai < 2; ++ai)
#pragma unroll
            for (int m = 0; m < 4; ++m) { const int t = 248 * tl - 1 + 62 * (2 * ai + wr) + 4 * fr + m; const bool in = (t >= 0) && (t < SEQ);
                rsa[ai][m] = in ? rowss[(size_t)sq * SEQ + t] : -1.0f; }
#pragma unroll
        for (int ai = 0; ai < 2; ++ai) {
            const int tb = 248 * tl - 1 + 62 * (2 * ai + wr) + 4 * fr;
            float g[4][8], rs[4], rsn[4];
#pragma unroll
            for (int m = 0; m < 4; ++m) {
                rs[m] = (rsa[ai][m] >= 0.f) ? __builtin_amdgcn_rsqf(rsa[ai][m] * (1.0f / 1024.0f) + 1e-6f) : 0.f;
                rsn[m] = rs[m] * -0.6931471805599453f;
#pragma unroll
                for (int j = 0; j < 8; ++j) g[m][j] = acc[ai][0][m][j >> 2][j & 3] * rs[m]; }
            float gl[8], gr[8];
#pragma unroll
            for (int j = 0; j < 8; ++j) { gl[j] = dpp_ror1(g[3][j]); gr[j] = dpp_ror15(g[0][j]); }
#pragma unroll
            for (int m = 0; m < 4; ++m) { const int t = tb + m; const int lr = 4 * fr + m;
                float h[8];
#pragma unroll
                for (int j = 0; j < 8; ++j) {
                    const float gp = (m == 0) ? gl[j] : g[m > 0 ? m - 1 : 0][j];
                    const float gn = (m == 3) ? gr[j] : g[m < 3 ? m + 1 : 3][j];
                    const float y = __builtin_fmaf(w2[j], gn, __builtin_fmaf(w1[j], g[m][j], __builtin_fmaf(w0[j], gp, bb[j])));
                    const float e = __builtin_amdgcn_exp2f(y);
                    h[j] = (y * __builtin_amdgcn_rcpf(1.0f + e)) * (acc[ai][1][m][j >> 2][j & 3] * rsn[m]);
                }
                if (lr >= 1 && lr <= 62 && t >= 0 && t < SEQ) {
                    u32x4 w; w.x = cvt_pk_bf16(h[0], h[1]); w.y = cvt_pk_bf16(h[2], h[3]); w.z = cvt_pk_bf16(h[4], h[5]); w.w = cvt_pk_bf16(h[6], h[7]);
                    *(u32x4*)(O + ((size_t)sq * SEQ + t) * FF + f0) = w; }
            }
        }
    }
};

template <class Epi, class Sched, bool ALIGN_EPI = false, bool SP2 = false>
__device__ __forceinline__ void gemm_phase(PG8_LAS unsigned char* lds, const Gemm g, const Sched& S, const Epi& E, const int wv) {
    int tid_; asm volatile("v_mbcnt_lo_u32_b32 %0, -1, 0\n\tv_mbcnt_hi_u32_b32 %0, -1, %0" : "=v"(tid_)); tid_ += wv * 64;
    const int tid = tid_, wid = __builtin_amdgcn_readfirstlane(tid >> 6), lane = tid & 63, wr = wid >> 2, wc = wid & 3, fr = lane & 15, fq = lane >> 4;
    const int K = g.K, nt = K / BK;
    unsigned voffA[2], voffB[2];
#pragma unroll
    for (int i = 0; i < 2; ++i) { int R, C; stage_rc(tid * 16 + i * 8192, R, C); const int Rb = Epi::PERM ? ((R & ~31) + perm32(R & 31)) : R;
        const int Ra = Epi::HALO ? (62 * (R >> 6) + 4 * (R & 15) + ((R >> 4) & 3)) : R;     voffA[i] = (unsigned)(Ra * K + C) * 2u; voffB[i] = (unsigned)(Rb * K + C) * 2u; }
    const size_t kstep = (size_t)(BK * 2);
    const size_t hstep = (size_t)HALF * K * 2;
    const size_t tstep = 2 * hstep; const size_t hstepA = Epi::HALO ? (size_t)124 * K * 2 : hstep; const size_t rowb = (size_t)K * 2;
    const unsigned ldsw = (unsigned)wid * 1024u;
    const int aoff = lds_byte(wr * 64 + fr, fq * 8), boff = lds_byte(wc * 32 + fr, fq * 8);
#define PG8_SA(b, h) (((b) * 2 + (h)) * HTB)
#define PG8_SB(b, h) ((4 + (b) * 2 + (h)) * HTB)
#define PG8_STAGE(bufoff, gbase, voff) do { _Pragma("unroll") for (int _i = 0; _i < 2; ++_i) \
        __builtin_amdgcn_global_load_lds((const unsigned*)((const char*)(gbase) + (voff)[_i]), (PG8_LAS unsigned*)(lds + (bufoff) + ldsw + _i * 8192), 16, 0, 0); } while (0)
#define PG8_LDA(dst, b, h) do { _Pragma("unroll") for (int m = 0; m < 4; ++m) _Pragma("unroll") for (int k = 0; k < 2; ++k) dst[m][k] = *(const PG8_LAS bf16x8*)(lds + PG8_SA(b, h) + aoff + m * 2048 + k * 1024); } while (0)
#define PG8_LDB(dst, b, h) do { _Pragma("unroll") for (int n = 0; n < 2; ++n) _Pragma("unroll") for (int k = 0; k < 2; ++k) dst[n][k] = *(const PG8_LAS bf16x8*)(lds + PG8_SB(b, h) + boff + n * 2048 + k * 1024); } while (0)
#define PG8_MMA(ai, bj, At, Bt) do { __builtin_amdgcn_s_setprio(1); _Pragma("unroll") for (int m = 0; m < 4; ++m) _Pragma("unroll") for (int n = 0; n < 2; ++n) _Pragma("unroll") for (int k = 0; k < 2; ++k) \
        acc[ai][bj][m][n] = __builtin_amdgcn_mfma_f32_16x16x32_bf16(Bt[n][k], At[m][k], acc[ai][bj][m][n], 0, 0, 0); __builtin_amdgcn_s_setprio(0); } while (0)
#define PG8_WAIT_V(n) asm volatile("s_waitcnt vmcnt(" #n ")" ::: "memory")
#define PG8_WAIT_L(n) asm volatile("s_waitcnt lgkmcnt(" #n ")" ::: "memory")
#define PG8_BAR __builtin_amdgcn_s_barrier()
#define PG8_SCHED __builtin_amdgcn_sched_barrier(0)
    Unit cur, nxt; int ui = 0;
    if (!S.next(0, cur)) return;
    f32x4 acc[2][2][4][2];
#pragma unroll
    for (int a = 0; a < 2; ++a)
#pragma unroll
        for (int b = 0; b < 2; ++b)
#pragma unroll
            for (int m = 0; m < 4; ++m)
#pragma unroll
                for (int n = 0; n < 2; ++n) acc[a][b][m][n] = (f32x4){0.f, 0.f, 0.f, 0.f};
    bf16x8 At[4][2], B0[2][2], B1[2][2];
    const char* cA = (const char*)g.A + (long)E.a_row(cur.pm) * (long)rowb; const char* cB = (const char*)g.Bt + (size_t)cur.pn * tstep;
    S.a_ready(cur);
    if constexpr (SP2) {
        PG8_STAGE(PG8_SB(0, 0), cB, voffB); PG8_STAGE(PG8_SB(0, 1), cB + hstep, voffB); PG8_STAGE(PG8_SA(0, 0), cA, voffA); PG8_STAGE(PG8_SA(0, 1), cA + hstepA, voffA);
        if (wr == 1) PG8_BAR;
        PG8_WAIT_V(2); PG8_BAR;
        PG8_STAGE(PG8_SB(1, 0), cB + kstep, voffB); PG8_STAGE(PG8_SA(1, 0), cA + kstep, voffA); PG8_STAGE(PG8_SB(1, 1), cB + hstep + kstep, voffB);
        PG8_WAIT_V(6); PG8_BAR;
    } else {
        PG8_STAGE(PG8_SB(0, 0), cB, voffB); PG8_STAGE(PG8_SA(0, 0), cA, voffA); PG8_STAGE(PG8_SB(0, 1), cB + hstep, voffB); PG8_STAGE(PG8_SA(0, 1), cA + hstepA, voffA);
        if (wr == 1) PG8_BAR;
        PG8_WAIT_V(4); PG8_BAR;
        PG8_STAGE(PG8_SB(1, 0), cB + kstep, voffB); PG8_STAGE(PG8_SA(1, 0), cA + kstep, voffA); PG8_STAGE(PG8_SB(1, 1), cB + hstep + kstep, voffB);
        PG8_WAIT_V(6); PG8_BAR;
    }
    for (;;) {
        const bool has_next = S.next(ui + 1, nxt);
        const char* nA = has_next ? (const char*)g.A + (long)E.a_row(nxt.pm) * (long)rowb : cA; const char* nB = has_next ? (const char*)g.Bt + (size_t)nxt.pn * tstep : cB;
        for (int t = 0; t < nt; t += 2) {
            const bool last = (t == nt - 2);
            const char* a1 = cA + (size_t)(t + 1) * kstep;
            const char* a2 = last ? nA : cA + (size_t)(t + 2) * kstep; const char* b2 = last ? nB : cB + (size_t)(t + 2) * kstep;
            const char* a3 = a2 + kstep; const char* b3 = b2 + kstep;
            if (last && has_next) S.a_ready(nxt);
            if constexpr (SP2) {
            PG8_LDB(B0, 0, 0); PG8_LDB(B1, 0, 1); PG8_SCHED; PG8_LDA(At, 0, 0); PG8_STAGE(PG8_SA(1, 1), a1 + hstepA, voffA);
            PG8_WAIT_V(8); PG8_WAIT_L(0); PG8_BAR; PG8_MMA(0, 0, At, B0); PG8_MMA(0, 1, At, B1); PG8_BAR; PG8_SCHED;
            PG8_LDA(At, 0, 1); PG8_STAGE(PG8_SB(0, 0), b2, voffB); PG8_STAGE(PG8_SB(0, 1), b2 + hstep, voffB); PG8_STAGE(PG8_SA(0, 0), a2, voffA);
            PG8_WAIT_V(8); PG8_WAIT_L(0); PG8_BAR; PG8_MMA(1, 0, At, B0); PG8_MMA(1, 1, At, B1); PG8_BAR; PG8_SCHED;
            PG8_LDB(B0, 1, 0); PG8_LDB(B1, 1, 1); PG8_SCHED; PG8_LDA(At, 1, 0); PG8_STAGE(PG8_SA(0, 1), a2 + hstepA, voffA);
            PG8_WAIT_V(8); PG8_WAIT_L(0); PG8_BAR; PG8_MMA(0, 0, At, B0); PG8_MMA(0, 1, At, B1); PG8_BAR; PG8_SCHED;
            PG8_LDA(At, 1, 1); PG8_STAGE(PG8_SB(1, 0), b3, voffB); PG8_STAGE(PG8_SB(1, 1), b3 + hstep, voffB); PG8_STAGE(PG8_SA(1, 0), a3, voffA);
            PG8_WAIT_V(8); PG8_WAIT_L(0); PG8_BAR; PG8_MMA(1, 0, At, B0); PG8_MMA(1, 1, At, B1); PG8_BAR; PG8_SCHED;
            } else {
            PG8_LDB(B0, 0, 0); PG8_SCHED; PG8_LDA(At, 0, 0); PG8_STAGE(PG8_SA(1, 1), a1 + hstepA, voffA);
            PG8_WAIT_L(8); PG8_BAR; PG8_WAIT_L(0); PG8_MMA(0, 0, At, B0); PG8_BAR; PG8_SCHED;
            PG8_LDB(B1, 0, 1); PG8_STAGE(PG8_SB(0, 0), b2, voffB);
            PG8_BAR; PG8_WAIT_L(0); PG8_MMA(0, 1, At, B1); PG8_BAR;
            PG8_LDA(At, 0, 1); PG8_STAGE(PG8_SA(0, 0), a2, voffA);
            PG8_BAR; PG8_WAIT_L(0); PG8_MMA(1, 0, At, B0); PG8_BAR; PG8_SCHED;
            PG8_STAGE(PG8_SB(0, 1), b2 + hstep, voffB);
            PG8_WAIT_V(6); PG8_BAR; PG8_MMA(1, 1, At, B1); PG8_BAR;
            PG8_LDB(B0, 1, 0); PG8_SCHED; PG8_LDA(At, 1, 0); PG8_STAGE(PG8_SA(0, 1), a2 + hstepA, voffA);
            PG8_WAIT_L(8); PG8_BAR; PG8_WAIT_L(0); PG8_MMA(0, 0, At, B0); PG8_BAR; PG8_SCHED;
            PG8_LDB(B1, 1, 1); PG8_STAGE(PG8_SB(1, 0), b3, voffB);
            PG8_BAR; PG8_WAIT_L(0); PG8_MMA(0, 1, At, B1); PG8_BAR;
            PG8_LDA(At, 1, 1); PG8_STAGE(PG8_SA(1, 0), a3, voffA);
            PG8_BAR; PG8_WAIT_L(0); PG8_MMA(1, 0, At, B0); PG8_BAR; PG8_SCHED;
            PG8_STAGE(PG8_SB(1, 1), b3 + hstep, voffB);
            PG8_WAIT_V(6); PG8_BAR; PG8_MMA(1, 1, At, B1); PG8_BAR;
            }
        }
        if constexpr (ALIGN_EPI) { if (wr == 0) PG8_BAR; }
        if constexpr (!Epi::AFTER_DRAIN) { E(acc, cur, wr, wc, fr, fq); S.done(cur); }
        if (!has_next) break;
#pragma unroll
        for (int a = 0; a < 2; ++a)
#pragma unroll
            for (int b = 0; b < 2; ++b)
#pragma unroll
                for (int m = 0; m < 4; ++m)
#pragma unroll
                    for (int n = 0; n < 2; ++n) acc[a][b][m][n] = (f32x4){0.f, 0.f, 0.f, 0.f};
        cur = nxt; cA = nA; cB = nB; ++ui;
        if constexpr (ALIGN_EPI) { if (wr == 1) PG8_BAR; }
    }
    PG8_WAIT_V(0);
    if constexpr (!ALIGN_EPI) { if (wr == 0) PG8_BAR; }
    PG8_BAR;
    if constexpr (Epi::AFTER_DRAIN) { E.fused(acc, cur, wr, wc, fr, fq, lds, wid, lane); S.done(cur); }
#undef PG8_SA
#undef PG8_SB
#undef PG8_STAGE
#undef PG8_LDA
#undef PG8_LDB
#undef PG8_MMA
#undef PG8_WAIT_V
#undef PG8_WAIT_L
#undef PG8_BAR
#undef PG8_SCHED
}
}
#define LAS __attribute__((address_space(3)))
typedef unsigned short bf16_t;
typedef short bf16x8 __attribute__((ext_vector_type(8)));
typedef float f32x4 __attribute__((ext_vector_type(4)));
typedef float f32x16 __attribute__((ext_vector_type(16)));
typedef unsigned u32x4 __attribute__((ext_vector_type(4)));
typedef unsigned u32x2 __attribute__((ext_vector_type(2)));
typedef float f32x2_t __attribute__((ext_vector_type(2)));
typedef __bf16 bf16x2_t __attribute__((ext_vector_type(2)));

constexpr int SEQ = 16384, NSEQ = 3, T = NSEQ * SEQ, DM = 1024, FF = 2816;
constexpr float C2_64 = 0.18033688011112042f, C2_96 = 0.14724444602590306f, EPSN = 1e-6f, LOG2E = 1.4426950408889634f;
constexpr int LDS_BYTES = 147456;

__device__ const float INVF_TAB[16] = {1.0f, 0.5623413324356079f, 0.3162277638912201f, 0.17782793939113617f, 0.10000000149011612f, 0.05623413249850273f, 0.03162277489900589f, 0.017782794311642647f,
    0.009999999776482582f, 0.005623413249850273f, 0.003162277629598975f, 0.0017782794311642647f, 0.0010000000474974513f, 0.000562341301701963f, 0.0003162277571391314f, 0.00017782794020604342f};
__device__ __forceinline__ constexpr float invf_c(int i) {
    switch (i) { case 0: return 1.0f; case 1: return 0.5623413324356079f; case 2: return 0.3162277638912201f; case 3: return 0.17782793939113617f; case 4: return 0.10000000149011612f;
        case 5: return 0.05623413249850273f; case 6: return 0.03162277489900589f; case 7: return 0.017782794311642647f; case 8: return 0.009999999776482582f; case 9: return 0.005623413249850273f;
        case 10: return 0.003162277629598975f; case 11: return 0.0017782794311642647f; case 12: return 0.0010000000474974513f; case 13: return 0.000562341301701963f;
        case 14: return 0.0003162277571391314f; default: return 0.00017782794020604342f; }
}
__device__ __forceinline__ float bflo(unsigned w) { return __uint_as_float(w << 16); }
__device__ __forceinline__ float bfhi(unsigned w) { return __uint_as_float(w & 0xffff0000u); }
__device__ __forceinline__ unsigned pk(float lo, float hi) { f32x2_t v = {lo, hi}; bf16x2_t b = __builtin_convertvector(v, bf16x2_t); return __builtin_bit_cast(unsigned, b); }
__device__ __forceinline__ float pairmax(float v) { auto rr = __builtin_amdgcn_permlane32_swap(__float_as_uint(v), __float_as_uint(v), false, false); return fmaxf(__uint_as_float(rr[0]), __uint_as_float(rr[1])); }
__device__ __forceinline__ float pairsum(float v) { auto rr = __builtin_amdgcn_permlane32_swap(__float_as_uint(v), __float_as_uint(v), false, false); return __uint_as_float(rr[0]) + __uint_as_float(rr[1]); }
__device__ __forceinline__ float wave_sum(float v) {
#pragma unroll
    for (int o = 1; o < 64; o <<= 1) v += __shfl_xor(v, o);
    return v;
}
__device__ __forceinline__ void rope_cs(int pos, float invf, float& c, float& s) {
    const float ang = (float)pos * invf;
    const float k = __builtin_rintf(ang * 0.15915494309189535f);
    float r = __builtin_fmaf(-k, 6.2831854820251465f, ang); r = __builtin_fmaf(-k, -1.7484556000744883e-07f, r);
    const float fr = r * 0.15915494309189535f;
    s = __builtin_amdgcn_sinf(fr); c = __builtin_amdgcn_cosf(fr);
}
__device__ __forceinline__ int crow(int r, int hi) { return (r & 3) + 8 * (r >> 2) + 4 * hi; }
#define BAR_LDS() asm volatile("s_waitcnt lgkmcnt(0)\n\ts_barrier" ::: "memory")

struct AttU {
    const bf16_t* q; const bf16_t* k; const bf16_t* kr; const bf16_t* vt; bf16_t* o;
    int kt0, kt1, tq0; const float* gain; float slope2, sink2;
};
template <int MODE> __device__ __forceinline__ void load_q(bf16x8 (&qf)[2][(MODE == 2) ? 6 : 4], const AttU& U, int lane) {
    constexpr int ND = (MODE == 2) ? 6 : 4, QP = 1536;
    const int r32 = lane & 31, hi = lane >> 5;
#pragma unroll
    for (int qb = 0; qb < 2; ++qb) {
        __builtin_amdgcn_sched_barrier(0);
        const bf16_t* src = U.q + (size_t)(32 * qb + r32) * QP + 8 * hi;
        u32x4 raw[ND];
#pragma unroll
        for (int d0 = 0; d0 < ND; ++d0) raw[d0] = *(const u32x4*)(src + 16 * d0);
        int pos = U.tq0 + 32 * qb + r32; asm volatile("" : "+v"(pos));
        if constexpr (MODE == 1) {
#pragma unroll
            for (int d0 = 0; d0 < ND; ++d0) qf[qb][d0] = __builtin_bit_cast(bf16x8, raw[d0]);
        } else if constexpr (MODE == 0) {
            float v[4][8]; float ss = 0.f;
#pragma unroll
            for (int d0 = 0; d0 < 4; ++d0)
#pragma unroll
                for (int j = 0; j < 4; ++j) { const unsigned w = raw[d0][j]; v[d0][2 * j] = bflo(w); v[d0][2 * j + 1] = bfhi(w); ss += v[d0][2 * j] * v[d0][2 * j] + v[d0][2 * j + 1] * v[d0][2 * j + 1]; }
            ss = pairsum(ss);
            const float rstd = rsqrtf(ss * (1.0f / 64.0f) + EPSN) * C2_64;
#pragma unroll
            for (int d0 = 0; d0 < 4; ++d0)
#pragma unroll
                for (int j = 0; j < 8; ++j) v[d0][j] *= rstd * U.gain[16 * d0 + 8 * hi + j];
            const int row = pos >> 6, col = pos & 63;
#pragma unroll
            for (int j = 0; j < 8; ++j) {
                __builtin_amdgcn_sched_barrier(0);
                const float fi = hi ? invf_c(8 + j) : invf_c(j); float c, s;
                rope_cs(row, fi, c, s); { const float x1 = v[0][j], x2 = v[1][j]; v[0][j] = x1 * c - x2 * s; v[1][j] = x2 * c + x1 * s; }
                rope_cs(col, fi, c, s); { const float x1 = v[2][j], x2 = v[3][j]; v[2][j] = x1 * c - x2 * s; v[3][j] = x2 * c + x1 * s; }
            }
#pragma unroll
            for (int d0 = 0; d0 < 4; ++d0) { u32x4 w; w.x = pk(v[d0][0], v[d0][1]); w.y = pk(v[d0][2], v[d0][3]); w.z = pk(v[d0][4], v[d0][5]); w.w = pk(v[d0][6], v[d0][7]); qf[qb][d0] = __builtin_bit_cast(bf16x8, w); }
        } else {
#pragma unroll
            for (int d0 = 0; d0 < 4; ++d0) qf[qb][d0] = __builtin_bit_cast(bf16x8, raw[d0]);
            float a[8], b[8];
#pragma unroll
            for (int j = 0; j < 4; ++j) { a[2 * j] = bflo(raw[ND - 2][j]); a[2 * j + 1] = bfhi(raw[ND - 2][j]); b[2 * j] = bflo(raw[ND - 1][j]); b[2 * j + 1] = bfhi(raw[ND - 1][j]); }
#pragma unroll
            for (int j = 0; j < 8; ++j) { __builtin_amdgcn_sched_barrier(0); const float fi = hi ? invf_c(8 + j) : invf_c(j); float c, s; rope_cs(pos, fi, c, s);
                const float x1 = a[j], x2 = b[j]; a[j] = x1 * c - x2 * s; b[j] = x2 * c + x1 * s; }
            u32x4 wa, wb; wa.x = pk(a[0], a[1]); wa.y = pk(a[2], a[3]); wa.z = pk(a[4], a[5]); wa.w = pk(a[6], a[7]); wb.x = pk(b[0], b[1]); wb.y = pk(b[2], b[3]); wb.z = pk(b[4], b[5]); wb.w = pk(b[6], b[7]);
            qf[qb][ND - 2] = __builtin_bit_cast(bf16x8, wa); qf[qb][ND - 1] = __builtin_bit_cast(bf16x8, wb);
        }
    }
}

__device__ __forceinline__ float fadd_s(float a, float b) { float r; asm("v_add_f32_e32 %0, %1, %2" : "=v"(r) : "v"(a), "v"(b)); return r; }
__device__ __forceinline__ float fsub_s(float a, float b) { float r; asm("v_sub_f32_e32 %0, %1, %2" : "=v"(r) : "v"(a), "v"(b)); return r; }
#define MFMA32(a, b, c) __builtin_amdgcn_mfma_f32_32x32x16_bf16(a, b, c, 0, 0, 0)
#define SBAR() __builtin_amdgcn_sched_barrier(0)
#define MX3(a, b, c) __builtin_fmaxf(__builtin_fmaxf((a), (b)), (c))

template <int MODE, bool FAST> __device__ __forceinline__ bool attn_unit(LAS unsigned char* lds, const AttU& U, const int wv) {
    constexpr int DK = (MODE == 2) ? 96 : 64, ND = DK / 16, KSTR = (MODE == 2) ? 208 : 144, VSTR = 144;
    constexpr int KP = MODE == 0 ? 128 : (MODE == 1 ? 1536 : 1024), VTS = MODE == 2 ? 65536 : 8192;
    constexpr int STG = 64 * KSTR + 64 * VSTR;
    constexpr float THR = 8.0f;
    int tid_; asm volatile("v_mbcnt_lo_u32_b32 %0, -1, 0\n\tv_mbcnt_hi_u32_b32 %0, -1, %0" : "=v"(tid_)); tid_ += wv * 64;
    const int tid = tid_, lane = tid & 63, r32 = lane & 31, hi = lane >> 5;
    bf16x8 qf[2][ND];
    load_q<MODE>(qf, U, lane);
    f32x16 o[2][2];
#pragma unroll
    for (int a = 0; a < 2; ++a)
#pragma unroll
        for (int b = 0; b < 2; ++b)
#pragma unroll
            for (int r = 0; r < 16; ++r) o[a][b][r] = 0.f;
    float mref[2], lsum[2]; bf16x8 qx[2]; bool bad_ = false;
    const bf16x8 kones = __builtin_bit_cast(bf16x8, (u32x4){hi == 0 ? 0x3f80u : 0u, 0u, 0u, 0u});
    { const unsigned wb0 = (MODE == 1 && !FAST) ? (pk(-U.sink2, 0.f) & 0xffffu) : 0u; const float m0 = -__uint_as_float(wb0 << 16);
      mref[0] = mref[1] = m0; qx[0] = __builtin_bit_cast(bf16x8, (u32x4){hi == 0 ? wb0 : 0u, 0u, 0u, 0u}); qx[1] = qx[0];
      lsum[0] = lsum[1] = (MODE == 1 && hi == 0) ? __builtin_amdgcn_exp2f(U.sink2 - m0) : 0.f; }
    const int krow = tid >> 3, kc = tid & 7;
    const unsigned kgo = (unsigned)(krow * KP + kc * 8) * 2u, krgo = (unsigned)(krow * 32 + kc * 4) * 2u, vgo = (unsigned)tid * 16u;
    const unsigned kdst = krow * KSTR + kc * 16, krdst = krow * KSTR + 128 + kc * 8, vdst = 64 * KSTR + krow * VSTR + kc * 16;
    u32x4 rk, rv, rk2, rv2; u32x2 rr = {0u, 0u}, rr2 = {0u, 0u};
#define ATT_LOADS(RK, RR, RV, tt) do { RK = *(const u32x4*)((const char*)(U.k + (size_t)(tt) * 64 * KP) + kgo); if (MODE == 2) RR = *(const u32x2*)((const char*)(U.kr + (size_t)(tt) * 64 * 32) + krgo); \
        RV = *(const u32x4*)((const char*)(U.vt + (size_t)(tt) * VTS) + vgo); } while (0)
#define ATT_STORES(RK, RR, RV, ss) do { LAS unsigned char* b_ = lds + (ss) * STG; *(LAS u32x4*)(b_ + kdst) = RK; if (MODE == 2) *(LAS u32x2*)(b_ + krdst) = RR; *(LAS u32x4*)(b_ + vdst) = RV; } while (0)
#define ATT_LOAD(tt) ATT_LOADS(rk, rr, rv, tt)
#define ATT_STORE(ss) ATT_STORES(rk, rr, rv, ss)
    const int NT = U.kt1 - U.kt0;
    ATT_LOAD(U.kt0); ATT_STORE(0);
    if (NT > 1) { ATT_LOAD(U.kt0 + 1); ATT_STORE(1); }
    if (NT > 2) ATT_LOAD(U.kt0 + 2);
    if constexpr (FAST) { if (NT > 3) ATT_LOADS(rk2, rr2, rv2, U.kt0 + 3); }
    BAR_LDS();
    f32x16 s[2]; bf16x8 pb[2][2];
    const unsigned koff = r32 * KSTR + hi * 16, voff = 64 * KSTR + r32 * VSTR + hi * 16;
#define ATT_QK(Y, sp, kh) do { LAS const unsigned char* kp_ = lds + (sp) * STG + koff + (kh) * 32 * KSTR; \
        if constexpr (FAST) s[Y] = MFMA32(*(LAS const bf16x8*)(kp_), qf[Y][0], (f32x16){0.f}); \
        else { s[Y] = MFMA32(kones, qx[Y], (f32x16){0.f}); s[Y] = MFMA32(*(LAS const bf16x8*)(kp_), qf[Y][0], s[Y]); } \
        _Pragma("unroll") for (int d0 = 1; d0 < ND; ++d0) s[Y] = MFMA32(*(LAS const bf16x8*)(kp_ + d0 * 32), qf[Y][d0], s[Y]); } while (0)
#define ATT_PV(Y, sp, kh) do { LAS const unsigned char* vp_ = lds + (sp) * STG + voff + (kh) * 64; \
        _Pragma("unroll") for (int db = 0; db < 2; ++db) _Pragma("unroll") for (int ks = 0; ks < 2; ++ks) \
            o[Y][db] = MFMA32(*(LAS const bf16x8*)(vp_ + db * 32 * VSTR + ks * 32), pb[Y][ks], o[Y][db]); } while (0)
#define ATT_ROWMAX(X) float rm_ = MX3(s[X][0], s[X][1], s[X][2]); rm_ = MX3(rm_, s[X][3], s[X][4]); rm_ = MX3(rm_, s[X][5], s[X][6]); rm_ = MX3(rm_, s[X][7], s[X][8]); \
        rm_ = MX3(rm_, s[X][9], s[X][10]); rm_ = MX3(rm_, s[X][11], s[X][12]); rm_ = MX3(rm_, s[X][13], s[X][14]); rm_ = __builtin_fmaxf(rm_, s[X][15]); rm_ = pairmax(rm_)
#define ATT_MF(k_) do { if ((k_) == 0) { if constexpr (!FAST) s[Y_] = MFMA32(kones, qx[Y_], (f32x16){0.f}); } \
        else if ((k_) == 1 && FAST) s[Y_] = MFMA32(kf_[0], qf[Y_][0], (f32x16){0.f}); \
        else if ((k_) <= ND) s[Y_] = MFMA32(kf_[(k_) - 1], qf[Y_][(k_) - 1], s[Y_]); \
        else o[Y_][((k_) - ND - 1) >> 1] = MFMA32(vf_[(k_) - ND - 1], pb[Y_][((k_) - ND - 1) & 1], o[Y_][((k_) - ND - 1) >> 1]); } while (0)
#define ATT_PHASE(X, Y, tx, kh_x, force, sp_v, kh_v, sp_k, kh_k) do { constexpr int Y_ = (Y); \
        LAS const unsigned char* vp_ = lds + (sp_v) * STG + voff + (kh_v) * 64; LAS const unsigned char* kp_ = lds + (sp_k) * STG + koff + (kh_k) * 32 * KSTR; \
        bf16x8 vf_[4], kf_[ND]; \
        _Pragma("unroll") for (int i_ = 0; i_ < (ND > 4 ? 3 : ND); ++i_) kf_[i_] = *(LAS const bf16x8*)(kp_ + i_ * 32); \
        if (MODE == 1) { int db_ = U.tq0 + 32 * (X) + r32 - 4 * hi - ((tx) * 64 + (kh_x) * 32); asm volatile("" : "+v"(db_)); \
            _Pragma("unroll") for (int r = 0; r < 16; ++r) { int d = db_ - ((r & 3) + 8 * (r >> 2)); d = d < 0 ? -d : d; s[X][r] = (d <= 128) ? s[X][r] - U.slope2 * (float)d : -INFINITY; } } \
        if (!FAST && (force)) {     \
            ATT_ROWMAX(X); const unsigned wb_ = pk(-(mref[X] + rm_), 0.f) & 0xffffu; \
            const float mn_ = -__uint_as_float(wb_ << 16), dl_ = mn_ - mref[X]; mref[X] = mn_; \
            qx[X] = __builtin_bit_cast(bf16x8, (u32x4){hi == 0 ? wb_ : 0u, 0u, 0u, 0u}); \
            _Pragma("unroll") for (int r = 0; r < 16; ++r) s[X][r] -= dl_; } \
        SBAR(); \
        float ps_ = 0.f; u32x4 w0_, w1_; \
        _Pragma("unroll") for (int g_ = 0; g_ < 8; ++g_) { \
            if (ND > 4 && g_ == 1) { _Pragma("unroll") for (int i_ = 3; i_ < ND; ++i_) kf_[i_] = *(LAS const bf16x8*)(kp_ + i_ * 32); } \
            if (g_ == (ND > 4 ? 4 : 1)) { _Pragma("unroll") for (int i_ = 0; i_ < 4; ++i_) vf_[i_] = *(LAS const bf16x8*)(vp_ + (i_ >> 1) * 32 * VSTR + (i_ & 1) * 32); } \
            ATT_MF(g_); \
            const float a_ = __builtin_amdgcn_exp2f(s[X][2 * g_]), b_ = __builtin_amdgcn_exp2f(s[X][2 * g_ + 1]); \
            ps_ += a_; ps_ += b_; unsigned w_ = pk(a_, b_); asm volatile("" : "+v"(w_), "+v"(ps_)); if (g_ < 4) w0_[g_ & 3] = w_; else w1_[g_ & 3] = w_; \
            SBAR(); } \
        _Pragma("unroll") for (int k_ = 8; k_ < ND + 5; ++k_) ATT_MF(k_); \
        if constexpr (FAST) { bad_ |= (__builtin_amdgcn_ballot_w64(!(ps_ <= 1.0995116e12f) || ((force) && ps_ < 9.3132257e-10f)) != 0ull); } \
        else if (__builtin_amdgcn_ballot_w64(!(ps_ <= 65536.0f)) != 0ull) {     \
            ATT_ROWMAX(X); const float d_ = fmaxf(rm_, 0.f); const unsigned wb_ = pk(-(mref[X] + d_), 0.f) & 0xffffu; \
            const float mn_ = -__uint_as_float(wb_ << 16), dl_ = mn_ - mref[X]; mref[X] = mn_; \
            qx[X] = __builtin_bit_cast(bf16x8, (u32x4){hi == 0 ? wb_ : 0u, 0u, 0u, 0u}); \
            const float f_ = __builtin_amdgcn_exp2f(-dl_); lsum[X] *= f_; _Pragma("unroll") for (int r = 0; r < 16; ++r) { o[X][0][r] *= f_; o[X][1][r] *= f_; } \
            ps_ = 0.f; \
            _Pragma("unroll") for (int g_ = 0; g_ < 8; ++g_) { s[X][2 * g_] -= dl_; s[X][2 * g_ + 1] -= dl_; \
                const float a_ = __builtin_amdgcn_exp2f(s[X][2 * g_]), b_ = __builtin_amdgcn_exp2f(s[X][2 * g_ + 1]); ps_ += a_; ps_ += b_; \
                const unsigned w_ = pk(a_, b_); if (g_ < 4) w0_[g_ & 3] = w_; else w1_[g_ & 3] = w_; } } \
        lsum[X] += ps_; pb[X][0] = __builtin_bit_cast(bf16x8, w0_); pb[X][1] = __builtin_bit_cast(bf16x8, w1_); SBAR(); } while (0)

    pb[1][0] = (bf16x8){0, 0, 0, 0, 0, 0, 0, 0}; pb[1][1] = pb[1][0];
    ATT_QK(0, 0, 0);
#define ATT_TILE(tt, DIST, RK, RR, RV) do { const int t = (tt); \
        const int j = t - U.kt0, sc = j & 3, sp = (j == 0) ? 0 : ((j + 3) & 3), sn = (j + 1) & 3; \
        if (j + 2 < NT) ATT_STORES(RK, RR, RV, (j + 2) & 3); \
        if (j + (DIST) < NT) ATT_LOADS(RK, RR, RV, t + (DIST)); \
        const bool f0 = (MODE != 1) && (j == 0); \
        ATT_PHASE(0, 1, t, 0, f0, sp, 1, sc, 0); \
        ATT_PHASE(1, 0, t, 0, f0, sc, 0, sc, 1); \
        ATT_PHASE(0, 1, t, 1, false, sc, 0, sc, 1); \
        ATT_PHASE(1, 0, t, 1, false, sc, 1, sn, 0); \
        BAR_LDS(); } while (0)
    if constexpr (FAST) {
        for (int t2 = U.kt0; t2 < U.kt1; t2 += 2) { ATT_TILE(t2, 4, rk, rr, rv); ATT_TILE(t2 + 1, 4, rk2, rr2, rv2); }
    } else {
        for (int t1 = U.kt0; t1 < U.kt1; ++t1) ATT_TILE(t1, 3, rk, rr, rv);
    }
    ATT_PV(1, (NT - 1) & 3, 1);
    BAR_LDS();
#undef ATT_LOAD
#undef ATT_LOADS
#undef ATT_STORES
#undef ATT_TILE
#undef ATT_STORE
#undef ATT_QK
#undef ATT_PV
#undef ATT_PHASE
#undef ATT_MF
#undef ATT_ROWMAX
    if constexpr (FAST) {
        volatile LAS unsigned* vote = (volatile LAS unsigned*)(lds + 131072 + 64);
        if (lane == 0) vote[wv] = bad_ ? 1u : 0u;
        BAR_LDS();
        const unsigned any_ = vote[0] | vote[1] | vote[2] | vote[3] | vote[4] | vote[5] | vote[6] | vote[7];
        BAR_LDS();
        if (any_) return true;
    }
#pragma unroll
    for (int qb = 0; qb < 2; ++qb) {
        const float inv = 1.0f / pairsum(lsum[qb]);
        bf16_t* op = U.o + (size_t)(32 * qb + r32) * DM + 4 * hi;
#pragma unroll
        for (int db = 0; db < 2; ++db)
#pragma unroll
            for (int g = 0; g < 4; ++g) { u32x2 w; w.x = pk(o[qb][db][4 * g] * inv, o[qb][db][4 * g + 1] * inv); w.y = pk(o[qb][db][4 * g + 2] * inv, o[qb][db][4 * g + 3] * inv);
                *(u32x2*)(op + 32 * db + 8 * g) = w; }
    }
    return false;
}

__device__ __forceinline__ void rms_row_bf16(const float* xrow, bf16_t* orow, int lane) {
    const f32x4* xr = (const f32x4*)xrow + lane; f32x4 v[4]; float s = 0.f;
#pragma unroll
    for (int j = 0; j < 4; ++j) { v[j] = xr[64 * j]; s += (v[j].x * v[j].x + v[j].y * v[j].y) + (v[j].z * v[j].z + v[j].w * v[j].w); }
    const float rstd = rsqrtf(wave_sum(s) * (1.0f / DM) + EPSN);
    u32x2* o8 = (u32x2*)orow + lane;
#pragma unroll
    for (int j = 0; j < 4; ++j) { u32x2 w; w.x = pk(v[j].x * rstd, v[j].y * rstd); w.y = pk(v[j].z * rstd, v[j].w * rstd); o8[64 * j] = w; }
}
__device__ __forceinline__ void rms_row_final(float* xrow, const float* g, int lane) {
    f32x4* xr = (f32x4*)xrow + lane; const f32x4* gr = (const f32x4*)g + lane; f32x4 v[4]; float s = 0.f;
#pragma unroll
    for (int j = 0; j < 4; ++j) { v[j] = xr[64 * j]; s += (v[j].x * v[j].x + v[j].y * v[j].y) + (v[j].z * v[j].z + v[j].w * v[j].w); }
    const float rstd = rsqrtf(wave_sum(s) * (1.0f / DM) + EPSN);
#pragma unroll
    for (int j = 0; j < 4; ++j) xr[64 * j] = v[j] * rstd * gr[64 * j];
}
struct WDesc { const float* W; int K, Nsrc, Nout; bf16_t* WT; const float* kgain; int mode; };
__device__ __forceinline__ void wprep_item(const WDesc& D, LAS float* scr, int item, int lane) {
    const int nblk = D.Nout / 32, kb = item / nblk, nb = item % nblk, k0 = 64 * kb, n0 = 32 * nb;
    int src0 = n0; float cs = 1.f;
    if (D.mode == 1) { if (n0 >= 768 && n0 < 1280) cs = C2_64; }
    else if (D.mode == 2) { if (n0 >= D.Nsrc) src0 = -1; }
    else if (D.mode == 3) cs = C2_96;
    else if (D.mode == 4) { src0 = (n0 < 1024) ? (n0 >> 6) * 128 + (n0 & 63) : ((n0 - 1024) >> 6) * 128 + 64 + (n0 & 63); }
    else if (D.mode == 5) { const int pn = n0 >> 8, j = n0 & 255; src0 = (j < 128) ? 128 * pn + j : 2816 + 128 * pn + (j - 128); }
#pragma unroll 8
    for (int i = 0; i < 32; ++i) { const int kk = 2 * i + (lane >> 5);
        float v = 0.f; if (src0 >= 0) { v = D.W[(size_t)(k0 + kk) * D.Nsrc + src0 + (lane & 31)] * cs; if (D.kgain) v *= D.kgain[k0 + kk]; }
        scr[kk * 33 + (lane & 31)] = v; }
    asm volatile("s_waitcnt lgkmcnt(0)" ::: "memory");
    const int c = lane & 7;
#pragma unroll
    for (int j = 0; j < 4; ++j) { const int n = (lane >> 3) + 8 * j; const LAS float* s = scr + (8 * c) * 33 + n;
        u32x4 o; o.x = pk(s[0 * 33], s[1 * 33]); o.y = pk(s[2 * 33], s[3 * 33]); o.z = pk(s[4 * 33], s[5 * 33]); o.w = pk(s[6 * 33], s[7 * 33]);
        *(u32x4*)(D.WT + (size_t)(n0 + n) * D.K + k0 + 8 * c) = o; }
    asm volatile("s_waitcnt lgkmcnt(0)" ::: "memory");
}
__device__ __forceinline__ void transpose_store(LAS unsigned char* wl, const u32x4 (&r)[8], bf16_t* dst, int lane) {
#pragma unroll
    for (int c = 0; c < 8; ++c) *(LAS u32x4*)(wl + lane * 144 + 16 * c) = r[c];
    asm volatile("s_waitcnt lgkmcnt(0)" ::: "memory");
    unsigned w[32];
#pragma unroll
    for (int pp = 0; pp < 32; ++pp) {
        const int p0 = 2 * pp, p1 = 2 * pp + 1;
        const int q0 = (p0 & 15) >> 2, q1 = (p1 & 15) >> 2;
        const int t0 = 16 * (p0 >> 4) + 4 * (q0 == 1 ? 2 : (q0 == 2 ? 1 : q0)) + (p0 & 3), t1 = 16 * (p1 >> 4) + 4 * (q1 == 1 ? 2 : (q1 == 2 ? 1 : q1)) + (p1 & 3);
        const unsigned lo = *(LAS const unsigned short*)(wl + t0 * 144 + 2 * lane), hi = *(LAS const unsigned short*)(wl + t1 * 144 + 2 * lane);
        w[pp] = lo | (hi << 16);
    }
#pragma unroll
    for (int c = 0; c < 8; ++c) { u32x4 o; o.x = w[4 * c]; o.y = w[4 * c + 1]; o.z = w[4 * c + 2]; o.w = w[4 * c + 3]; *(u32x4*)(dst + lane * 64 + 8 * c) = o; }
    asm volatile("s_waitcnt lgkmcnt(0)" ::: "memory");
}

#define XB_TMO      128
#define XB_XCNT(j)  (256  + 64 * (j))
#define XB_XSUB(j)  (1280 + 64 * (j))
#define XB_XGEN(j)  (2304 + 64 * (j))
#define XB_TOP      3328
#define XB_TOPGEN   3392
#define XCD_BAR_WORDS 3456
#define XB_SPIN_CAP (1u << 18)

__device__ __forceinline__ unsigned xb_ld(unsigned* p)              { return __hip_atomic_load(p, __ATOMIC_RELAXED, __HIP_MEMORY_SCOPE_AGENT); }
__device__ __forceinline__ unsigned xb_add(unsigned* p, unsigned v) { return __hip_atomic_fetch_add(p, v, __ATOMIC_RELAXED, __HIP_MEMORY_SCOPE_AGENT); }
__device__ __forceinline__ unsigned xb_xcc_id() { return (unsigned)__builtin_amdgcn_s_getreg((3 << 11) | 20) & 0xFu; }
#define XB_SPIN(cond, bar) do { unsigned _sp = 0; while (cond) { __builtin_amdgcn_s_sleep(1); \
    if ((++_sp & 255u) == 0u) { if (xb_ld(&(bar)[XB_TMO])) break; if (_sp > XB_SPIN_CAP) { atomicAdd(&(bar)[XB_TMO], 1u); break; } } } } while (0)

struct XcdBarrier { unsigned* bar; unsigned x; volatile LAS unsigned* st; };
__device__ __forceinline__ void xcd_barrier_complete(unsigned* bar, unsigned x, unsigned& nloc, unsigned& nx) {
    const unsigned G = gridDim.x * gridDim.y * gridDim.z;
    unsigned sum, cnt, mine, sp = 0u;
    for (;;) {
        sum = 0u; cnt = 0u; mine = 0u;
#pragma unroll
        for (unsigned j = 0; j < 16; ++j) { const unsigned c = xb_ld(&bar[XB_XCNT(j)]); sum += c; cnt += (c > 0u) ? 1u : 0u; mine = (j == x) ? c : mine; }
        if (sum == G) break;
        __builtin_amdgcn_s_sleep(1);
        if ((++sp & 255u) == 0u) { if (xb_ld(&bar[XB_TMO])) break; if (sp > XB_SPIN_CAP) { atomicAdd(&bar[XB_TMO], 1u); break; } }
    }
    nloc = mine > 0u ? mine : 1u; nx = cnt > 0u ? cnt : 1u;
}

__device__ __forceinline__ void xcd_barrier(const XcdBarrier& b, const bool is_t0) {
    asm volatile("s_waitcnt vmcnt(0)" ::: "memory");
    __syncthreads();
    if (is_t0) {
        unsigned* bar = b.bar;
        __builtin_amdgcn_s_waitcnt(0);
        unsigned nloc = b.st[0], nx = b.st[1];
        if (nloc == 0u) { xcd_barrier_complete(bar, b.x, nloc, nx); b.st[0] = nloc; b.st[1] = nx; }
        const unsigned old = xb_add(&bar[XB_XSUB(b.x)], 1u);
        const unsigned gen = old / nloc;
        if (old + 1u == (gen + 1u) * nloc) {
            __builtin_amdgcn_fence(__ATOMIC_RELEASE, "agent");
            asm volatile("s_waitcnt vmcnt(0)" ::: "memory");
            const unsigned og = xb_add(&bar[XB_TOP], 1u);
            const unsigned tg = og / nx;
            if (og + 1u == (tg + 1u) * nx) xb_add(&bar[XB_TOPGEN], 1u);
            else XB_SPIN(xb_ld(&bar[XB_TOPGEN]) == tg, bar);
            __builtin_amdgcn_fence(__ATOMIC_ACQUIRE, "agent");
            xb_add(&bar[XB_XGEN(b.x)], 1u);
            asm volatile("s_waitcnt vmcnt(0)" ::: "memory");
        } else {
            XB_SPIN(xb_ld(&bar[XB_XGEN(b.x)]) == gen, bar);
            __builtin_amdgcn_fence(__ATOMIC_ACQUIRE, "agent");
            asm volatile("s_waitcnt vmcnt(0)" ::: "memory");
        }
    }
    __syncthreads();
}

constexpr size_t MiB = 1u << 20;
constexpr size_t WS_WIN0 = 0, WS_WOUT0 = 3 * MiB, WS_WDN = 5 * MiB, WS_WUQ = 7 * MiB, WS_WUKV = 9 * MiB, WS_WOUT1 = 10 * MiB, WS_WUP0 = 12 * MiB, WS_WUP1 = 23 * MiB,
                 WS_WDOWN0 = 34 * MiB, WS_WDOWN1 = 40 * MiB, WS_KROPE = 46 * MiB, WS_BAR = 49 * MiB, WS_ROWSS = 49 * MiB + 65536;
constexpr size_t WS_H = 50 * MiB + 4096;
constexpr size_t WS_CKVN = 50 * MiB + 4096 + 40 * MiB;
constexpr size_t WS_A = 147 * MiB;
constexpr size_t WS_B = 291 * MiB;
constexpr size_t WS_KA = WS_B, WS_VAT = WS_B + 12 * MiB, WS_VBT = WS_B + 24 * MiB;
constexpr size_t WS_KNOPE = WS_B, WS_VRAW = WS_B + 96 * MiB;
constexpr size_t WS_HA = WS_A;
constexpr size_t WS_HID = WS_A + 97 * MiB;
constexpr size_t WS_END = 508 * MiB;

struct Args { const float* in[20]; float* out_; unsigned char* ws_; };
#ifndef PHM
#define PHM 0xFFFFFFFFu
#endif
#define PH(k) ((PHM >> (k)) & 1u)
#ifndef REP_THIN
#define REP_THIN 1
#endif
#ifndef REP_UP
#define REP_UP 1
#endif
#ifndef REP_L0
#define REP_L0 1
#endif
#ifndef REP_MLA
#define REP_MLA 1
#endif

__global__ void __launch_bounds__(512) fwd_megakernel(Args a) {
    extern __shared__ __attribute__((aligned(16))) unsigned char lds_raw[];
    cg::grid_group grid = cg::this_grid();
    LAS unsigned char* lds = (LAS unsigned char*)lds_raw;
    int tid, lane, gw; const __attribute__((address_space(4))) Args* ap;
#define ws (ap->ws_)
#define out (ap->out_)
#define xp (ap->in[0])
#define xs (ap->in[1])
#define Hb ((bf16_t*)(ap->ws_ + WS_H))
#define QKV0 ((bf16_t*)(ap->ws_ + WS_A))
    const int wave = __builtin_amdgcn_readfirstlane(threadIdx.x >> 6);
    const int G = gridDim.x, bx = blockIdx.x, NGW = G * 8;
#define REFRESH() do { asm volatile("v_mbcnt_lo_u32_b32 %0, -1, 0\n\tv_mbcnt_hi_u32_b32 %0, -1, %0" : "=v"(lane)); tid = wave * 64 + lane; gw = bx * 8 + wave; ap = (const __attribute__((address_space(4))) Args*)__builtin_amdgcn_kernarg_segment_ptr(); asm volatile("" : "+s"(ap)); } while (0)
    REFRESH();
    volatile LAS unsigned* xb_st = (volatile LAS unsigned*)(lds + 131072);
    if (threadIdx.x < 2) xb_st[threadIdx.x] = 0u;
    __syncthreads();
#define GRID_BAR() do { REFRESH(); XcdBarrier xb_; xb_.bar = (unsigned*)(ap->ws_ + WS_BAR); xb_.x = xb_xcc_id(); xb_.st = xb_st; xcd_barrier(xb_, tid == 0); REFRESH(); } while (0)
#define xcd_ok (gridDim.x == 256u)
#define xcd ((int)(blockIdx.x & 7u))
#define slot ((int)(blockIdx.x >> 3))

    _Pragma("nounroll") for (int rt_ = 0; rt_ < REP_THIN; ++rt_) if (PH(0)) {
        LAS float* scr = (LAS float*)(lds + wave * 16384);
        WDesc D[10];
        D[0] = WDesc{ap->in[5], 1024, 1536, 1536, (bf16_t*)(ws + WS_WIN0), ap->in[2], 1};
        D[1] = WDesc{ap->in[9], 1024, 1024, 1024, (bf16_t*)(ws + WS_WOUT0), nullptr, 0};
        D[2] = WDesc{ap->in[10], 1024, 672, 768, (bf16_t*)(ws + WS_WDN), ap->in[2] + 1024, 2};
        D[3] = WDesc{ap->in[13], 384, 1536, 1536, (bf16_t*)(ws + WS_WUQ), ap->in[11], 3};
        D[4] = WDesc{ap->in[14], 256, 2048, 2048, (bf16_t*)(ws + WS_WUKV), ap->in[12], 4};
        D[5] = WDesc{ap->in[15], 1024, 1024, 1024, (bf16_t*)(ws + WS_WOUT1), nullptr, 0};
        D[6] = WDesc{ap->in[16], 1024, 5632, 5632, (bf16_t*)(ws + WS_WUP0), ap->in[3], 5};
        D[7] = WDesc{ap->in[16] + (size_t)1024 * 5632, 1024, 5632, 5632, (bf16_t*)(ws + WS_WUP1), ap->in[3] + 1024, 5};
        D[8] = WDesc{ap->in[19], 2816, 1024, 1024, (bf16_t*)(ws + WS_WDOWN0), nullptr, 0};
        D[9] = WDesc{ap->in[19] + (size_t)2816 * 1024, 2816, 1024, 1024, (bf16_t*)(ws + WS_WDOWN1), nullptr, 0};
        int base = 0;
#pragma unroll
        for (int m = 0; m < 10; ++m) {
            const int ni = (D[m].K / 64) * (D[m].Nout / 32);
            int first = gw - (base % NGW); if (first < 0) first += NGW;
            for (int it = first; it < ni; it += NGW) wprep_item(D[m], scr, it, lane);
            base += ni;
        }
        for (int i = bx * 512 + tid; i < 3 * T; i += G * 512) ((float*)(ap->ws_ + WS_ROWSS))[i] = 0.f;
        if (bx == 0) for (int i = tid; i < XCD_BAR_WORDS; i += 512) ((unsigned*)(ap->ws_ + WS_BAR))[i] = 0u;
        for (int m = gw, it_ = 0; it_ < T / 2048; ++it_, m += 2048) rms_row_bf16(m < SEQ ? xp + (size_t)m * DM : xs + (size_t)(m - SEQ) * DM, Hb + (size_t)m * DM, lane);
    }
    grid.sync(); REFRESH();
    if (tid == 0) (void)xb_add(&((unsigned*)(ap->ws_ + WS_BAR))[XB_XCNT(xb_xcc_id())], 1u);

    if (PH(1)) {
        pg8::Gemm g{Hb, (const bf16_t*)(ws + WS_WIN0), T, 1536, 1024}; pg8::StaticOrder S; S.init(T, 1536, G, bx);
        pg8::EpiBf16 E{QKV0, 1536, 0, 0, nullptr};
        pg8::gemm_phase<pg8::EpiBf16, pg8::StaticOrder, true, true>(lds, g, S, E, wave);
    }
    GRID_BAR();
    _Pragma("nounroll") for (int rt_ = 0; rt_ < REP_THIN; ++rt_) if (PH(2)) {
        LAS unsigned char* wl = lds + wave * 9216;
        bf16_t* KA = (bf16_t*)(ws + WS_KA);
        for (int it = gw; it < 768 * 6; it += NGW) {
            const int tl = it / 6, job = it % 6; const int tok = tl * 64 + lane;
            if (job < 4) {
                const int hh = job & 1, isb = job >> 1;
                const bf16_t* src = QKV0 + (size_t)tok * 1536 + (isb ? 1408 : 640) + 64 * hh;
                u32x4 r[8];
#pragma unroll
                for (int c = 0; c < 8; ++c) r[c] = *(const u32x4*)(src + 8 * c);
                bf16_t* dst = (bf16_t*)(ws + (isb ? WS_VBT : WS_VAT)) + ((size_t)tl * 2 + hh) * 4096;
                transpose_store(wl, r, dst, lane);
            } else {
                const int hh = job - 4;
                const bf16_t* src = QKV0 + (size_t)tok * 1536 + 512 + 64 * hh;
                float v[64]; float ss = 0.f;
#pragma unroll
                for (int c = 0; c < 8; ++c) { const u32x4 w = *(const u32x4*)(src + 8 * c);
#pragma unroll
                    for (int j = 0; j < 4; ++j) { v[8 * c + 2 * j] = bflo(w[j]); v[8 * c + 2 * j + 1] = bfhi(w[j]); } }
#pragma unroll
                for (int d = 0; d < 64; ++d) ss += v[d] * v[d];
                const float rstd = rsqrtf(ss * (1.0f / 64.0f) + EPSN);
                const float* kg = ap->in[7];
#pragma unroll
                for (int d = 0; d < 64; ++d) v[d] *= rstd * kg[d];
                int pos = tok & (SEQ - 1); asm volatile("" : "+v"(pos)); const int row = pos >> 6, col = pos & 63;
#pragma unroll
                for (int i = 0; i < 16; ++i) { float c, s;
                    rope_cs(row, invf_c(i), c, s); { const float x1 = v[i], x2 = v[16 + i]; v[i] = x1 * c - x2 * s; v[16 + i] = x2 * c + x1 * s; }
                    rope_cs(col, invf_c(i), c, s); { const float x1 = v[32 + i], x2 = v[48 + i]; v[32 + i] = x1 * c - x2 * s; v[48 + i] = x2 * c + x1 * s; } }
                bf16_t* dst = KA + (size_t)tok * 128 + 64 * hh;
#pragma unroll
                for (int c = 0; c < 8; ++c) { u32x4 w; w.x = pk(v[8 * c], v[8 * c + 1]); w.y = pk(v[8 * c + 2], v[8 * c + 3]); w.z = pk(v[8 * c + 4], v[8 * c + 5]); w.w = pk(v[8 * c + 6], v[8 * c + 7]); *(u32x4*)(dst + 8 * c) = w; }
            }
        }
    }
    GRID_BAR();
    if (PH(3)) {
#define L0_UNITS(CALL0, CALL1) \
        for (int pass = 0; pass < 2; ++pass) \
            for (int i_ = 0; i_ < 3 * REP_L0; ++i_) { const int i = i_ % 3; const unsigned ubit = 1u << (3 * pass + i); \
                const int unit = 96 * xcd + 32 * i + slot; \
                const int combo = unit >> 7, qb = unit & 127, sq = combo >> 1, kvh = combo & 1; \
                const int head = 4 * kvh + (wave >> 1), tq0 = 128 * qb + 64 * (wave & 1); \
                const size_t row0 = (size_t)sq * SEQ; \
                AttU U; \
                U.kr = nullptr; U.gain = ap->in[6]; U.tq0 = tq0; \
                U.o = Hb + (row0 + tq0) * DM + (pass ? 512 : 0) + 64 * head; \
                if (pass == 0) { \
                    U.q = QKV0 + (row0 + tq0) * 1536 + 64 * head; \
                    U.k = (const bf16_t*)(ws + WS_KA) + row0 * 128 + 64 * kvh; \
                    U.vt = (const bf16_t*)(ws + WS_VAT) + ((size_t)sq * 256 * 2 + kvh) * 4096; \
                    U.kt0 = 0; U.kt1 = 256; U.slope2 = 0.f; U.sink2 = 0.f; \
                    if (PH(20)) { CALL0; } \
                } else { \
                    U.q = QKV0 + (row0 + tq0) * 1536 + 768 + 64 * head; \
                    U.k = QKV0 + row0 * 1536 + 1280 + 64 * kvh; \
                    U.vt = (const bf16_t*)(ws + WS_VBT) + ((size_t)sq * 256 * 2 + kvh) * 4096; \
                    U.kt0 = qb > 0 ? 2 * (qb - 1) : 0; U.kt1 = qb < 127 ? 2 * (qb + 2) : 256; \
                    U.slope2 = LOG2E * exp2f(-(float)(head + 1)); U.sink2 = LOG2E * ap->in[8][head]; \
                    if (PH(21)) { CALL1; } \
                } \
            }
        unsigned badmask = 0u;
        L0_UNITS(if ((attn_unit<0, true>(lds, U, wave))) badmask |= ubit, if ((attn_unit<1, true>(lds, U, wave))) badmask |= ubit)
        if (badmask) {
            L0_UNITS(if (badmask & ubit) (void)(attn_unit<0, false>(lds, U, wave)), if (badmask & ubit) (void)(attn_unit<1, false>(lds, U, wave))) }
#undef L0_UNITS
    }
    GRID_BAR();
    if (PH(4)) {
        pg8::Gemm g{Hb, (const bf16_t*)(ws + WS_WOUT0), T, 1024, 1024}; pg8::StaticOrder S; S.init(T, 1024, G, bx);
        pg8::EpiResT<false> E{xp, xs, SEQ, nullptr, nullptr, DM, (bf16_t*)(ws + WS_HA), (float*)(ws + WS_ROWSS)};
        pg8::gemm_phase<pg8::EpiResT<false>, pg8::StaticOrder, true, true>(lds, g, S, E, wave);
    }
    GRID_BAR();

    _Pragma("unroll") for (int layer = 0; layer < 2; ++layer) {
        if (layer == 1) {
            bf16_t* CDOWN = (bf16_t*)(ws + WS_B);
            if (PH(9)) {
                pg8::Gemm g{(const bf16_t*)out  , (const bf16_t*)(ws + WS_WDN), T, 768, 1024}; pg8::StaticOrder S; S.init(T, 768, G, bx);
                pg8::EpiBf16 E{CDOWN, 768, 0, 0, (const float*)(ws + WS_ROWSS) + T};
                pg8::gemm_phase<pg8::EpiBf16, pg8::StaticOrder, true, true>(lds, g, S, E, wave);
            }
            GRID_BAR();
            bf16_t* CQN = Hb; bf16_t* CKVN = (bf16_t*)(ws + WS_CKVN); bf16_t* KROPE = (bf16_t*)(ws + WS_KROPE);
            _Pragma("nounroll") for (int rt_ = 0; rt_ < REP_THIN; ++rt_) if (PH(10)) for (int m = gw, it_ = 0; it_ < T / 2048; ++it_, m += 2048) {
                const bf16_t* row = CDOWN + (size_t)m * 768;
                const unsigned* pq = (const unsigned*)row + 3 * lane; const unsigned* pkv = (const unsigned*)(row + 384) + 2 * lane;
                const unsigned q0 = pq[0], q1 = pq[1], q2 = pq[2], k0 = pkv[0], k1 = pkv[1];
                float sq_ = bflo(q0) * bflo(q0) + bfhi(q0) * bfhi(q0) + bflo(q1) * bflo(q1) + bfhi(q1) * bfhi(q1) + bflo(q2) * bflo(q2) + bfhi(q2) * bfhi(q2);
                float sk_ = bflo(k0) * bflo(k0) + bfhi(k0) * bfhi(k0) + bflo(k1) * bflo(k1) + bfhi(k1) * bfhi(k1);
                const float rq = rsqrtf(wave_sum(sq_) * (1.0f / 384.0f) + EPSN), rk = rsqrtf(wave_sum(sk_) * (1.0f / 256.0f) + EPSN);
                unsigned* oq = (unsigned*)(CQN + (size_t)m * 384) + 3 * lane; unsigned* ok = (unsigned*)(CKVN + (size_t)m * 256) + 2 * lane;
                oq[0] = pk(bflo(q0) * rq, bfhi(q0) * rq); oq[1] = pk(bflo(q1) * rq, bfhi(q1) * rq); oq[2] = pk(bflo(q2) * rq, bfhi(q2) * rq);
                ok[0] = pk(bflo(k0) * rk, bfhi(k0) * rk); ok[1] = pk(bflo(k1) * rk, bfhi(k1) * rk);
                if (lane < 16) { const float x1 = __uint_as_float((unsigned)row[640 + lane] << 16), x2 = __uint_as_float((unsigned)row[656 + lane] << 16);
                    float c, s; rope_cs(m & (SEQ - 1), INVF_TAB[lane], c, s);
                    const unsigned w = pk(x1 * c - x2 * s, x2 * c + x1 * s);
                    KROPE[(size_t)m * 32 + lane] = (bf16_t)(w & 0xffffu); KROPE[(size_t)m * 32 + 16 + lane] = (bf16_t)(w >> 16); }
            }
            GRID_BAR();
            bf16_t* QRAW = (bf16_t*)(ws + WS_A);
            if (PH(11)) {
                { pg8::Gemm g{CQN, (const bf16_t*)(ws + WS_WUQ), T, 1536, 384}; pg8::StaticOrder S; S.init(T, 1536, G, bx);
                  pg8::EpiBf16 E{QRAW, 1536, 0, 0, nullptr};
                  pg8::gemm_phase<pg8::EpiBf16, pg8::StaticOrder, true, true>(lds, g, S, E, wave); }
                { pg8::Gemm g{CKVN, (const bf16_t*)(ws + WS_WUKV), T, 2048, 256}; pg8::StaticOrder S; S.init(T, 2048, G, bx);
                  pg8::EpiBf16 E{(bf16_t*)(ws + WS_KNOPE), 1024, 1024, (WS_VRAW - WS_KNOPE) / 2, nullptr};
                  pg8::gemm_phase<pg8::EpiBf16, pg8::StaticOrder, true, true>(lds, g, S, E, wave); }
            }
            GRID_BAR();
            if (PH(12)) {
                LAS unsigned char* wl = lds + wave * 9216;
                bf16_t* VR = (bf16_t*)(ws + WS_VRAW);
                for (int tl = bx; tl < 768; tl += G) {
                    const bf16_t* src = VR + ((size_t)tl * 64 + lane) * 1024;
                    u32x4 r0[8], r1[8];
#pragma unroll
                    for (int c = 0; c < 8; ++c) { r0[c] = *(const u32x4*)(src + 64 * wave + 8 * c); r1[c] = *(const u32x4*)(src + 64 * (wave + 8) + 8 * c); }
                    asm volatile("s_waitcnt vmcnt(0)" ::: "memory");
                    __syncthreads();
                    transpose_store(wl, r0, VR + ((size_t)tl * 16 + wave) * 4096, lane);
                    transpose_store(wl, r1, VR + ((size_t)tl * 16 + wave + 8) * 4096, lane);
                }
            }
            GRID_BAR();
            if (PH(13)) {
#define L1_UNITS(CALL) \
                for (int i_ = 0; i_ < 6 * REP_MLA; ++i_) { const int i = i_ % 6; const unsigned ubit = 1u << i; \
                    const int combo = xcd * 6 + i, qb = slot; \
                    const int sq = combo >> 4, head = combo & 15, tq0 = 512 * qb + 64 * wave; \
                    const size_t row0 = (size_t)sq * SEQ; \
                    AttU U; \
                    U.q = QRAW + (row0 + tq0) * 1536 + 96 * head; \
                    U.k = (const bf16_t*)(ws + WS_KNOPE) + row0 * 1024 + 64 * head; \
                    U.kr = KROPE + row0 * 32; \
                    U.vt = (const bf16_t*)(ws + WS_VRAW) + ((size_t)sq * 256 * 16 + head) * 4096; \
                    U.o = Hb + (row0 + tq0) * DM + 64 * head; \
                    U.kt0 = 0; U.kt1 = 256; U.tq0 = tq0; U.gain = nullptr; U.slope2 = 0.f; U.sink2 = 0.f; \
                    CALL; \
                }
                unsigned badmask = 0u;
                L1_UNITS(if ((attn_unit<2, true>(lds, U, wave))) badmask |= ubit)
                if (badmask) {
                    L1_UNITS(if (badmask & ubit) (void)(attn_unit<2, false>(lds, U, wave))) }
#undef L1_UNITS
            }
            GRID_BAR();
            if (PH(14)) {
                pg8::Gemm g{Hb, (const bf16_t*)(ws + WS_WOUT1), T, 1024, 1024}; pg8::StaticOrder S; S.init(T, 1024, G, bx);
                pg8::EpiResT<true> E{nullptr, nullptr, 0, (const bf16_t*)out, nullptr, DM, (bf16_t*)(ws + WS_HA), (float*)(ws + WS_ROWSS) + 2 * T};
                pg8::gemm_phase<pg8::EpiResT<true>, pg8::StaticOrder, true, true>(lds, g, S, E, wave);
            }
            GRID_BAR();
        }
        bf16_t* HID = (bf16_t*)(ws + WS_HID);
        _Pragma("nounroll") for (int rep_ = 0; rep_ < REP_UP; ++rep_) if (PH(6)) {
            pg8::Gemm g{(const bf16_t*)(ws + WS_HA), (const bf16_t*)(ws + (layer ? WS_WUP1 : WS_WUP0)), T, 5632, 1024}; pg8::StaticOrder S; S.init_t(3 * pg8::EpiGlu::TPS, 22, G, bx);
            pg8::EpiGlu E{HID, ap->in[17] + (size_t)layer * 3 * FF, ap->in[18] + (size_t)layer * FF, (const float*)(ws + WS_ROWSS) + (size_t)layer * 2 * T};
            pg8::gemm_phase<pg8::EpiGlu, pg8::StaticOrder, true, true>(lds, g, S, E, wave);
        }
        GRID_BAR();
        if (PH(7)) {
            pg8::Gemm g{HID, (const bf16_t*)(ws + (layer ? WS_WDOWN1 : WS_WDOWN0)), T, 1024, 2816}; pg8::StaticOrder S; S.init(T, 1024, G, bx);
            pg8::EpiResT<true> E{nullptr, nullptr, 0, (const bf16_t*)(ws + WS_HA), layer ? out : (float*)nullptr, DM, layer ? (bf16_t*)nullptr : (bf16_t*)out, (float*)(ws + WS_ROWSS) + T};
            pg8::gemm_phase<pg8::EpiResT<true>, pg8::StaticOrder, true, true>(lds, g, S, E, wave);
        }
        GRID_BAR();
    }
    for (int m = gw, it_ = 0; it_ < T / 2048; ++it_, m += 2048) rms_row_final(out + (size_t)m * DM, ap->in[4], lane);
}

#undef ws
#undef out
#undef xp
#undef xs
#undef Hb
#undef QKV0
extern "C" void kernel_launch(void* const* d_in, const int* in_sizes, int n_in, void* d_out, int out_size, void* d_ws, size_t ws_size, hipStream_t stream) {
    static int grid = 0;
    if (grid == 0) {
        if (n_in != 20 || out_size != T * DM || ws_size < WS_END) { fprintf(stderr, "kernel_launch: unexpected shapes (n_in %d out %d ws %zu)\n", n_in, out_size, ws_size); grid = -1; return; }
        int dev = 0, cus = 0, per_cu = 0;
        (void)hipGetDevice(&dev); (void)hipDeviceGetAttribute(&cus, hipDeviceAttributeMultiprocessorCount, dev);
        (void)hipFuncSetAttribute((const void*)fwd_megakernel, hipFuncAttributeMaxDynamicSharedMemorySize, LDS_BYTES);
        (void)hipOccupancyMaxActiveBlocksPerMultiprocessor(&per_cu, (const void*)fwd_megakernel, 512, LDS_BYTES);
        if (per_cu < 1) { fprintf(stderr, "kernel_launch: occupancy query says %d blocks/CU\n", per_cu); per_cu = 1; }
        (void)hipGetLastError();
        grid = cus * per_cu;
        if (grid != 256) { fprintf(stderr, "kernel_launch: this kernel's unit maps need exactly 256 workgroups (got %d)\n", grid); grid = -1; return; }
    }
    if (grid < 0) return;
    Args a{};
    for (int i = 0; i < 20; ++i) a.in[i] = (const float*)d_in[i];
    a.out_ = (float*)d_out; a.ws_ = (unsigned char*)d_ws;
    void* args[] = {&a};
    hipError_t e = hipLaunchCooperativeKernel((const void*)fwd_megakernel, dim3(grid), dim3(512), args, LDS_BYTES, stream);
    if (e != hipSuccess) fprintf(stderr, "cooperative launch failed: %s (grid %d)\n", hipGetErrorString(e), grid);
}
```

```cpp
#include <hip/hip_runtime.h>
#include <hip/hip_cooperative_groups.h>
#include <cstdio>
#include <cstdint>
namespace cg = cooperative_groups;

namespace pg8 {
#define PG8_LAS __attribute__((address_space(3)))
typedef unsigned short bf16_t;
typedef short bf16x8 __attribute__((ext_vector_type(8)));
typedef float f32x4 __attribute__((ext_vector_type(4)));
typedef unsigned u32x4 __attribute__((ext_vector_type(4)));
constexpr int BM = 256, BK = 64, HALF = 128, HTB = HALF * BK * 2  , STAGE_BYTES = 8 * HTB, NXCD = 8, WGM = 8;

__host__ __device__ __forceinline__ int lds_byte(int r, int c) { const int st = (r >> 4) * 2 + (c >> 5), rr = r & 15, cc = c & 31, ob = rr * 64 + cc * 2; return st * 1024 + (ob ^ (((ob >> 9) & 1) << 5)); }
__host__ __device__ __forceinline__ void stage_rc(int b, int& R, int& C) { const int st = b / 1024, sb = b % 1024, swz = sb ^ (((sb >> 9) & 1) << 5); R = (st >> 1) * 16 + swz / 64; C = (st & 1) * 32 + (swz % 64) / 2; }
__host__ __device__ __forceinline__ int perm32(int rho) { const int n = rho >> 4, i = rho & 15; return 8 * (i >> 2) + 4 * n + (i & 3); }

struct Unit { int pm, pn; };
struct Gemm { const bf16_t* A; const bf16_t* Bt; int M, N, K; };

struct StaticOrder {
    int nM, nN, nwg, G, c;
    __host__ __device__ void init_t(int nM_, int nN_, int G_, int c_) { nM = nM_; nN = nN_; nwg = nM * nN; G = G_; c = c_; }
    __host__ __device__ void init(int M, int N, int G_, int c_) { init_t(M / BM, N / BM, G_, c_); }
    __host__ __device__ bool next(int i, Unit& u) const {
        const long L = (long)i * G + c; if (L >= nwg) return false;
        int wgid = (int)L; { const int q = nwg / NXCD, r = nwg % NXCD, xcd = wgid % NXCD, off = wgid / NXCD; wgid = (xcd < r ? xcd * (q + 1) : r * (q + 1) + (xcd - r) * q) + off; }
        const int nig = WGM * nN, gid = wgid / nig, fm = gid * WGM, gsz = (nM - fm) < WGM ? (nM - fm) : WGM;
        u.pm = fm + ((wgid % nig) % gsz); u.pn = (wgid % nig) / gsz; return true;
    }
    __device__ __forceinline__ void a_ready(const Unit&) const {}
    __device__ __forceinline__ void done(const Unit&) const {}
};

__device__ __forceinline__ unsigned cvt_pk_bf16(float lo, float hi) { unsigned r; asm volatile("v_cvt_pk_bf16_f32 %0, %1, %2" : "=v"(r) : "v"(lo), "v"(hi)); return r; }

struct EpiBf16 {
    static constexpr bool PERM = true, AFTER_DRAIN = false, HALO = false;
    bf16_t* O; int ldc; int split_cols; size_t split_stride;
    const float* rowss;
    __device__ __forceinline__ long a_row(int pm) const { return (long)pm * BM; }
    __device__ __forceinline__ void operator()(const f32x4 (&acc)[2][2][4][2], const Unit& u, int wr, int wc, int fr, int fq) const {
        int colt = u.pn * BM; bf16_t* base = O; if (split_cols) { const int t = colt / split_cols; base += (size_t)t * split_stride; colt -= t * split_cols; }
        const int row0 = u.pm * BM + wr * 64 + fr; const int col0 = colt + wc * 32 + 8 * fq;
#pragma unroll
        for (int ai = 0; ai < 2; ++ai)
#pragma unroll
            for (int m = 0; m < 4; ++m) { bf16_t* rowp = base + (size_t)(row0 + ai * HALF + m * 16) * ldc + col0;
                const float rs = rowss ? __builtin_amdgcn_rsqf(rowss[row0 + ai * HALF + m * 16] * (1.0f / 1024.0f) + 1e-6f) : 1.0f;
#pragma unroll
                for (int bj = 0; bj < 2; ++bj) { const f32x4 v0 = acc[ai][bj][m][0] * rs, v1 = acc[ai][bj][m][1] * rs;
                    u32x4 w; w.x = cvt_pk_bf16(v0[0], v0[1]); w.y = cvt_pk_bf16(v0[2], v0[3]); w.z = cvt_pk_bf16(v1[0], v1[1]); w.w = cvt_pk_bf16(v1[2], v1[3]);
                    *(u32x4*)(rowp + bj * HALF) = w; } }
    }
};
template <bool BASEB> struct EpiResT {
    static constexpr bool PERM = true, AFTER_DRAIN = false, HALO = false;
    const float* base0; const float* base1; int split; const bf16_t* baseb; float* out; int ldc; bf16_t* hb; float* rowss;
    __device__ __forceinline__ long a_row(int pm) const { return (long)pm * BM; }
    __device__ __forceinline__ void operator()(const f32x4 (&acc)[2][2][4][2], const Unit& u, int wr, int wc, int fr, int fq) const {
        const int row0 = u.pm * BM + wr * 64 + fr; const int col0 = u.pn * BM + wc * 32 + 8 * fq;
        constexpr int NB = BASEB ? 4 : 2;
#pragma unroll
        for (int ai = 0; ai < 2; ++ai)
#pragma unroll
            for (int mb = 0; mb < 4; mb += NB) {
                f32x4 b0[NB][2], b1[NB][2];
                if (BASEB) { u32x4 w[NB][2];
#pragma unroll
                    for (int q = 0; q < NB; ++q)
#pragma unroll
                        for (int bj = 0; bj < 2; ++bj) w[q][bj] = *(const u32x4*)(baseb + (size_t)(row0 + ai * HALF + (mb + q) * 16) * ldc + col0 + bj * HALF);
#pragma unroll
                    for (int q = 0; q < NB; ++q)
#pragma unroll
                        for (int bj = 0; bj < 2; ++bj) { const u32x4 v = w[q][bj];
                            b0[q][bj] = (f32x4){__uint_as_float(v.x << 16), __uint_as_float(v.x & 0xffff0000u), __uint_as_float(v.y << 16), __uint_as_float(v.y & 0xffff0000u)};
                            b1[q][bj] = (f32x4){__uint_as_float(v.z << 16), __uint_as_float(v.z & 0xffff0000u), __uint_as_float(v.w << 16), __uint_as_float(v.w & 0xffff0000u)}; }
                } else {
#pragma unroll
                    for (int q = 0; q < NB; ++q) { const int row = row0 + ai * HALF + (mb + q) * 16;
                        const float* bp = (row < split ? base0 + (size_t)row * ldc : base1 + (size_t)(row - split) * ldc) + col0;
#pragma unroll
                        for (int bj = 0; bj < 2; ++bj) { b0[q][bj] = *(const f32x4*)(bp + bj * HALF); b1[q][bj] = *(const f32x4*)(bp + bj * HALF + 4); } }
                }
#pragma unroll
                for (int q = 0; q < NB; ++q) { const int m = mb + q; const int row = row0 + ai * HALF + m * 16;
                    float ss = 0.f;
#pragma unroll
                    for (int bj = 0; bj < 2; ++bj) {
                        const f32x4 x0 = acc[ai][bj][m][0] + b0[q][bj], x1 = acc[ai][bj][m][1] + b1[q][bj];
                        if (out) { float* op = out + (size_t)row * ldc + col0 + bj * HALF; *(f32x4*)op = x0; *(f32x4*)(op + 4) = x1; }
                        if (hb) { ss += (x0[0] * x0[0] + x0[1] * x0[1]) + (x0[2] * x0[2] + x0[3] * x0[3]) + (x1[0] * x1[0] + x1[1] * x1[1]) + (x1[2] * x1[2] + x1[3] * x1[3]);
                            u32x4 w; w.x = cvt_pk_bf16(x0[0], x0[1]); w.y = cvt_pk_bf16(x0[2], x0[3]); w.z = cvt_pk_bf16(x1[0], x1[1]); w.w = cvt_pk_bf16(x1[2], x1[3]);
                            *(u32x4*)(hb + (size_t)row * ldc + col0 + bj * HALF) = w; } }
                    if (hb) { ss += __shfl_xor(ss, 16); ss += __shfl_xor(ss, 32); if (fq == 0) atomicAdd(rowss + row, ss); } }
            }
    }
};
__device__ __forceinline__ float dpp_ror1(float v)  { return __builtin_bit_cast(float, __builtin_amdgcn_mov_dpp(__builtin_bit_cast(int, v), 0x121, 0xf, 0xf, true)); }
__device__ __forceinline__ float dpp_ror15(float v) { return __builtin_bit_cast(float, __builtin_amdgcn_mov_dpp(__builtin_bit_cast(int, v), 0x12F, 0xf, 0xf, true)); }
struct EpiGlu {
    static constexpr bool PERM = true, AFTER_DRAIN = false, HALO = true;
    static constexpr int SEQ = 16384, TPS = 67  , FF = 2816;
    bf16_t* O; const float* cw; const float* cb; const float* rowss;
    __device__ __forceinline__ long a_row(int pm) const { const int sq = pm / TPS, tl = pm % TPS; return (long)sq * SEQ + 248 * tl - 1; }
    __device__ __forceinline__ void operator()(const f32x4 (&acc)[2][2][4][2], const Unit& u, int wr, int wc, int fr, int fq) const {
        const int sq = u.pm / TPS, tl = u.pm % TPS; const int f0 = u.pn * 128 + wc * 32 + 8 * fq;
        float w0[8], w1[8], w2[8], bb[8];
#pragma unroll
        for (int j = 0; j < 8; ++j) { constexpr float NL = -1.4426950408889634f;
            w0[j] = NL * cw[f0 + j]; w1[j] = NL * cw[FF + f0 + j]; w2[j] = NL * cw[2 * FF + f0 + j]; bb[j] = NL * cb[f0 + j]; }
        float rsa[2][4];
#pragma unroll
        for (int ai = 0; ai < 2; ++ai)
#pragma unroll
            for (int m = 0; m < 4; ++m) { const int t = 248 * tl - 1 + 62 * (2 * ai + wr) + 4 * fr + m; const bool in = (t >= 0) && (t < SEQ);
                rsa[ai][m] = in ? rowss[(size_t)sq * SEQ + t] : -1.0f; }
#pragma unroll
        for (int ai = 0; ai < 2; ++ai) {
            const int tb = 248 * tl - 1 + 62 * (2 * ai + wr) + 4 * fr;
            float g[4][8], rs[4], rsn[4];
#pragma unroll
            for (int m = 0; m < 4; ++m) {
                rs[m] = (rsa[ai][m] >= 0.f) ? __builtin_amdgcn_rsqf(rsa[ai][m] * (1.0f / 1024.0f) + 1e-6f) : 0.f;
                rsn[m] = rs[m] * -0.6931471805599453f;
#pragma unroll
                for (int j = 0; j < 8; ++j) g[m][j] = acc[ai][0][m][j >> 2][j & 3] * rs[m]; }
            float gl[8], gr[8];
#pragma unroll
            for (int j = 0; j < 8; ++j) { gl[j] = dpp_ror1(g[3][j]); gr[j] = dpp_ror15(g[0][j]); }
#pragma unroll
            for (int m = 0; m < 4; ++m) { const int t = tb + m; const int lr = 4 * fr + m;
                float h[8];
#pragma unroll
                for (int j = 0; j < 8; ++j) {
                    const float gp = (m == 0) ? gl[j] : g[m > 0 ? m - 1 : 0][j];
                    const float gn = (m == 3) ? gr[j] : g[m < 3 ? m + 1 : 3][j];
                    const float y = __builtin_fmaf(w2[j], gn, __builtin_fmaf(w1[j], g[m][j], __builtin_fmaf(w0[j], gp, bb[j])));
                    const float e = __builtin_amdgcn_exp2f(y);
                    h[j] = (y * __builtin_amdgcn_rcpf(1.0f + e)) * (acc[ai][1][m][j >> 2][j & 3] * rsn[m]);
                }
                if (lr >= 1 && lr <= 62 && t >= 0 && t < SEQ) {
                    u32x4 w; w.x = cvt_pk_bf16(h[0], h[1]); w.y = cvt_pk_bf16(h[2], h[3]); w.z = cvt_pk_bf16(h[4], h[5]); w.w = cvt_pk_bf16(h[6], h[7]);
                    *(u32x4*)(O + ((size_t)sq * SEQ + t) * FF + f0) = w; }
            }
        }
    }
};

template <class Epi, class Sched, bool ALIGN_EPI = false, bool SP2 = false>
__device__ __forceinline__ void gemm_phase(PG8_LAS unsigned char* lds, const Gemm g, const Sched& S, const Epi& E, const int wv) {
    int tid_; asm volatile("v_mbcnt_lo_u32_b32 %0, -1, 0\n\tv_mbcnt_hi_u32_b32 %0, -1, %0" : "=v"(tid_)); tid_ += wv * 64;
    const int tid = tid_, wid = __builtin_amdgcn_readfirstlane(tid >> 6), lane = tid & 63, wr = wid >> 2, wc = wid & 3, fr = lane & 15, fq = lane >> 4;
    const int K = g.K, nt = K / BK;
    unsigned voffA[2], voffB[2];
#pragma unroll
    for (int i = 0; i < 2; ++i) { int R, C; stage_rc(tid * 16 + i * 8192, R, C); const int Rb = Epi::PERM ? ((R & ~31) + perm32(R & 31)) : R;
        const int Ra = Epi::HALO ? (62 * (R >> 6) + 4 * (R & 15) + ((R >> 4) & 3)) : R;     voffA[i] = (unsigned)(Ra * K + C) * 2u; voffB[i] = (unsigned)(Rb * K + C) * 2u; }
    const size_t kstep = (size_t)(BK * 2);
    const size_t hstep = (size_t)HALF * K * 2;
    const size_t tstep = 2 * hstep; const size_t hstepA = Epi::HALO ? (size_t)124 * K * 2 : hstep; const size_t rowb = (size_t)K * 2;
    const unsigned ldsw = (unsigned)wid * 1024u;
    const int aoff = lds_byte(wr * 64 + fr, fq * 8), boff = lds_byte(wc * 32 + fr, fq * 8);
#define PG8_SA(b, h) (((b) * 2 + (h)) * HTB)
#define PG8_SB(b, h) ((4 + (b) * 2 + (h)) * HTB)
#define PG8_STAGE(bufoff, gbase, voff) do { _Pragma("unroll") for (int _i = 0; _i < 2; ++_i) \
        __builtin_amdgcn_global_load_lds((const unsigned*)((const char*)(gbase) + (voff)[_i]), (PG8_LAS unsigned*)(lds + (bufoff) + ldsw + _i * 8192), 16, 0, 0); } while (0)
#define PG8_LDA(dst, b, h) do { _Pragma("unroll") for (int m = 0; m < 4; ++m) _Pragma("unroll") for (int k = 0; k < 2; ++k) dst[m][k] = *(const PG8_LAS bf16x8*)(lds + PG8_SA(b, h) + aoff + m * 2048 + k * 1024); } while (0)
#define PG8_LDB(dst, b, h) do { _Pragma("unroll") for (int n = 0; n < 2; ++n) _Pragma("unroll") for (int k = 0; k < 2; ++k) dst[n][k] = *(const PG8_LAS bf16x8*)(lds + PG8_SB(b, h) + boff + n * 2048 + k * 1024); } while (0)
#define PG8_MMA(ai, bj, At, Bt) do { __builtin_amdgcn_s_setprio(1); _Pragma("unroll") for (int m = 0; m < 4; ++m) _Pragma("unroll") for (int n = 0; n < 2; ++n) _Pragma("unroll") for (int k = 0; k < 2; ++k) \
        acc[ai][bj][m][n] = __builtin_amdgcn_mfma_f32_16x16x32_bf16(Bt[n][k], At[m][k], acc[ai][bj][m][n], 0, 0, 0); __builtin_amdgcn_s_setprio(0); } while (0)
#define PG8_WAIT_V(n) asm volatile("s_waitcnt vmcnt(" #n ")" ::: "memory")
#define PG8_WAIT_L(n) asm volatile("s_waitcnt lgkmcnt(" #n ")" ::: "memory")
#define PG8_BAR __builtin_amdgcn_s_barrier()
#define PG8_SCHED __builtin_amdgcn_sched_barrier(0)
    Unit cur, nxt; int ui = 0;
    if (!S.next(0, cur)) return;
    f32x4 acc[2][2][4][2];
#pragma unroll
    for (int a = 0; a < 2; ++a)
#pragma unroll
        for (int b = 0; b < 2; ++b)
#pragma unroll
            for (int m = 0; m < 4; ++m)
#pragma unroll
                for (int n = 0; n < 2; ++n) acc[a][b][m][n] = (f32x4){0.f, 0.f, 0.f, 0.f};
    bf16x8 At[4][2], B0[2][2], B1[2][2];
    const char* cA = (const char*)g.A + (long)E.a_row(cur.pm) * (long)rowb; const char* cB = (const char*)g.Bt + (size_t)cur.pn * tstep;
    S.a_ready(cur);
    if constexpr (SP2) {
        PG8_STAGE(PG8_SB(0, 0), cB, voffB); PG8_STAGE(PG8_SB(0, 1), cB + hstep, voffB); PG8_STAGE(PG8_SA(0, 0), cA, voffA); PG8_STAGE(PG8_SA(0, 1), cA + hstepA, voffA);
        if (wr == 1) PG8_BAR;
        PG8_WAIT_V(2); PG8_BAR;
        PG8_STAGE(PG8_SB(1, 0), cB + kstep, voffB); PG8_STAGE(PG8_SA(1, 0), cA + kstep, voffA); PG8_STAGE(PG8_SB(1, 1), cB + hstep + kstep, voffB);
        PG8_WAIT_V(6); PG8_BAR;
    } else {
        PG8_STAGE(PG8_SB(0, 0), cB, voffB); PG8_STAGE(PG8_SA(0, 0), cA, voffA); PG8_STAGE(PG8_SB(0, 1), cB + hstep, voffB); PG8_STAGE(PG8_SA(0, 1), cA + hstepA, voffA);
        if (wr == 1) PG8_BAR;
        PG8_WAIT_V(4); PG8_BAR;
        PG8_STAGE(PG8_SB(1, 0), cB + kstep, voffB); PG8_STAGE(PG8_SA(1, 0), cA + kstep, voffA); PG8_STAGE(PG8_SB(1, 1), cB + hstep + kstep, voffB);
        PG8_WAIT_V(6); PG8_BAR;
    }
    for (;;) {
        const bool has_next = S.next(ui + 1, nxt);
        const char* nA = has_next ? (const char*)g.A + (long)E.a_row(nxt.pm) * (long)rowb : cA; const char* nB = has_next ? (const char*)g.Bt + (size_t)nxt.pn * tstep : cB;
        for (int t = 0; t < nt; t += 2) {
            const bool last = (t == nt - 2);
            const char* a1 = cA + (size_t)(t + 1) * kstep;
            const char* a2 = last ? nA : cA + (size_t)(t + 2) * kstep; const char* b2 = last ? nB : cB + (size_t)(t + 2) * kstep;
            const char* a3 = a2 + kstep; const char* b3 = b2 + kstep;
            if (last && has_next) S.a_ready(nxt);
            if constexpr (SP2) {
            PG8_LDB(B0, 0, 0); PG8_LDB(B1, 0, 1); PG8_SCHED; PG8_LDA(At, 0, 0); PG8_STAGE(PG8_SA(1, 1), a1 + hstepA, voffA);
            PG8_WAIT_V(8); PG8_WAIT_L(0); PG8_BAR; PG8_MMA(0, 0, At, B0); PG8_MMA(0, 1, At, B1); PG8_BAR; PG8_SCHED;
            PG8_LDA(At, 0, 1); PG8_STAGE(PG8_SB(0, 0), b2, voffB); PG8_STAGE(PG8_SB(0, 1), b2 + hstep, voffB); PG8_STAGE(PG8_SA(0, 0), a2, voffA);
            PG8_WAIT_V(8); PG8_WAIT_L(0); PG8_BAR; PG8_MMA(1, 0, At, B0); PG8_MMA(1, 1, At, B1); PG8_BAR; PG8_SCHED;
            PG8_LDB(B0, 1, 0); PG8_LDB(B1, 1, 1); PG8_SCHED; PG8_LDA(At, 1, 0); PG8_STAGE(PG8_SA(0, 1), a2 + hstepA, voffA);
            PG8_WAIT_V(8); PG8_WAIT_L(0); PG8_BAR; PG8_MMA(0, 0, At, B0); PG8_MMA(0, 1, At, B1); PG8_BAR; PG8_SCHED;
            PG8_LDA(At, 1, 1); PG8_STAGE(PG8_SB(1, 0), b3, voffB); PG8_STAGE(PG8_SB(1, 1), b3 + hstep, voffB); PG8_STAGE(PG8_SA(1, 0), a3, voffA);
            PG8_WAIT_V(8); PG8_WAIT_L(0); PG8_BAR; PG8_MMA(1, 0, At, B0); PG8_MMA(1, 1, At, B1); PG8_BAR; PG8_SCHED;
            } else {
            PG8_LDB(B0, 0, 0); PG8_SCHED; PG8_LDA(At, 0, 0); PG8_STAGE(PG8_SA(1, 1), a1 + hstepA, voffA);
            PG8_WAIT_L(8); PG8_BAR; PG8_WAIT_L(0); PG8_MMA(0, 0, At, B0); PG8_BAR; PG8_SCHED;
            PG8_LDB(B1, 0, 1); PG8_STAGE(PG8_SB(0, 0), b2, voffB);
            PG8_BAR; PG8_WAIT_L(0); PG8_MMA(0, 1, At, B1); PG8_BAR;
            PG8_LDA(At, 0, 1); PG8_STAGE(PG8_SA(0, 0), a2, voffA);
            PG8_BAR; PG8_WAIT_L(0); PG8_MMA(1, 0, At, B0); PG8_BAR; PG8_SCHED;
            PG8_STAGE(PG8_SB(0, 1), b2 + hstep, voffB);
            PG8_WAIT_V(6); PG8_BAR; PG8_MMA(1, 1, At, B1); PG8_BAR;
            PG8_LDB(B0, 1, 0); PG8_SCHED; PG8_LDA(At, 1, 0); PG8_STAGE(PG8_SA(0, 1), a2 + hstepA, voffA);
            PG8_WAIT_L(8); PG8_BAR; PG8_WAIT_L(0); PG8_MMA(0, 0, At, B0); PG8_BAR; PG8_SCHED;
            PG8_LDB(B1, 1, 1); PG8_STAGE(PG8_SB(1, 0), b3, voffB);
            PG8_BAR; PG8_WAIT_L(0); PG8_MMA(0, 1, At, B1); PG8_BAR;
            PG8_LDA(At, 1, 1); PG8_STAGE(PG8_SA(1, 0), a3, voffA);
            PG8_BAR; PG8_WAIT_L(0); PG8_MMA(1, 0, At, B0); PG8_BAR; PG8_SCHED;
            PG8_STAGE(PG8_SB(1, 1), b3 + hstep, voffB);
            PG8_WAIT_V(6); PG8_BAR; PG8_MMA(1, 1, At, B1); PG8_BAR;
            }
        }
        if constexpr (ALIGN_EPI) { if (wr == 0) PG8_BAR; }
        if constexpr (!Epi::AFTER_DRAIN) { E(acc, cur, wr, wc, fr, fq); S.done(cur); }
        if (!has_next) break;
#pragma unroll
        for (int a = 0; a < 2; ++a)
#pragma unroll
            for (int b = 0; b < 2; ++b)
#pragma unroll
                for (int m = 0; m < 4; ++m)
#pragma unroll
                    for (int n = 0; n < 2; ++n) acc[a][b][m][n] = (f32x4){0.f, 0.f, 0.f, 0.f};
        cur = nxt; cA = nA; cB = nB; ++ui;
        if constexpr (ALIGN_EPI) { if (wr == 1) PG8_BAR; }
    }
    PG8_WAIT_V(0);
    if constexpr (!ALIGN_EPI) { if (wr == 0) PG8_BAR; }
    PG8_BAR;
    if constexpr (Epi::AFTER_DRAIN) { E.fused(acc, cur, wr, wc, fr, fq, lds, wid, lane); S.done(cur); }
#undef PG8_SA
#undef PG8_SB
#undef PG8_STAGE
#undef PG8_LDA
#undef PG8_LDB
#undef PG8_MMA
#undef PG8_WAIT_V
#undef PG8_WAIT_L
#undef PG8_BAR
#undef PG8_SCHED
}
}
#define LAS __attribute__((address_space(3)))
typedef unsigned short bf16_t;
typedef short bf16x8 __attribute__((ext_vector_type(8)));
typedef float f32x4 __attribute__((ext_vector_type(4)));
typedef float f32x16 __attribute__((ext_vector_type(16)));
typedef unsigned u32x4 __attribute__((ext_vector_type(4)));
typedef unsigned u32x2 __attribute__((ext_vector_type(2)));
typedef float f32x2_t __attribute__((ext_vector_type(2)));
typedef __bf16 bf16x2_t __attribute__((ext_vector_type(2)));

constexpr int SEQ = 16384, NSEQ = 3, T = NSEQ * SEQ, DM = 1024, FF = 2816;
constexpr float C2_64 = 0.18033688011112042f, C2_96 = 0.14724444602590306f, EPSN = 1e-6f, LOG2E = 1.4426950408889634f;
constexpr int LDS_BYTES = 147456;

__device__ const float INVF_TAB[16] = {1.0f, 0.5623413324356079f, 0.3162277638912201f, 0.17782793939113617f, 0.10000000149011612f, 0.05623413249850273f, 0.03162277489900589f, 0.017782794311642647f,
    0.009999999776482582f, 0.005623413249850273f, 0.003162277629598975f, 0.0017782794311642647f, 0.0010000000474974513f, 0.000562341301701963f, 0.0003162277571391314f, 0.00017782794020604342f};
__device__ __forceinline__ constexpr float invf_c(int i) {
    switch (i) { case 0: return 1.0f; case 1: return 0.5623413324356079f; case 2: return 0.3162277638912201f; case 3: return 0.17782793939113617f; case 4: return 0.10000000149011612f;
        case 5: return 0.05623413249850273f; case 6: return 0.03162277489900589f; case 7: return 0.017782794311642647f; case 8: return 0.009999999776482582f; case 9: return 0.005623413249850273f;
        case 10: return 0.003162277629598975f; case 11: return 0.0017782794311642647f; case 12: return 0.0010000000474974513f; case 13: return 0.000562341301701963f;
        case 14: return 0.0003162277571391314f; default: return 0.00017782794020604342f; }
}
__device__ __forceinline__ float bflo(unsigned w) { return __uint_as_float(w << 16); }
__device__ __forceinline__ float bfhi(unsigned w) { return __uint_as_float(w & 0xffff0000u); }
__device__ __forceinline__ unsigned pk(float lo, float hi) { f32x2_t v = {lo, hi}; bf16x2_t b = __builtin_convertvector(v, bf16x2_t); return __builtin_bit_cast(unsigned, b); }
__device__ __forceinline__ float pairmax(float v) { auto rr = __builtin_amdgcn_permlane32_swap(__float_as_uint(v), __float_as_uint(v), false, false); return fmaxf(__uint_as_float(rr[0]), __uint_as_float(rr[1])); }
__device__ __forceinline__ float pairsum(float v) { auto rr = __builtin_amdgcn_permlane32_swap(__float_as_uint(v), __float_as_uint(v), false, false); return __uint_as_float(rr[0]) + __uint_as_float(rr[1]); }
__device__ __forceinline__ float wave_sum(float v) {
#pragma unroll
    for (int o = 1; o < 64; o <<= 1) v += __shfl_xor(v, o);
    return v;
}
__device__ __forceinline__ void rope_cs(int pos, float invf, float& c, float& s) {
    const float ang = (float)pos * invf;
    const float k = __builtin_rintf(ang * 0.15915494309189535f);
    float r = __builtin_fmaf(-k, 6.2831854820251465f, ang); r = __builtin_fmaf(-k, -1.7484556000744883e-07f, r);
    const float fr = r * 0.15915494309189535f;
    s = __builtin_amdgcn_sinf(fr); c = __builtin_amdgcn_cosf(fr);
}
__device__ __forceinline__ int crow(int r, int hi) { return (r & 3) + 8 * (r >> 2) + 4 * hi; }
#define BAR_LDS() asm volatile("s_waitcnt lgkmcnt(0)\n\ts_barrier" ::: "memory")

struct AttU {
    const bf16_t* q; const bf16_t* k; const bf16_t* kr; const bf16_t* vt; bf16_t* o;
    int kt0, kt1, tq0; const float* gain; float slope2, sink2;
};
template <int MODE> __device__ __forceinline__ void load_q(bf16x8 (&qf)[2][(MODE == 2) ? 6 : 4], const AttU& U, int lane) {
    constexpr int ND = (MODE == 2) ? 6 : 4, QP = 1536;
    const int r32 = lane & 31, hi = lane >> 5;
#pragma unroll
    for (int qb = 0; qb < 2; ++qb) {
        __builtin_amdgcn_sched_barrier(0);
        const bf16_t* src = U.q + (size_t)(32 * qb + r32) * QP + 8 * hi;
        u32x4 raw[ND];
#pragma unroll
        for (int d0 = 0; d0 < ND; ++d0) raw[d0] = *(const u32x4*)(src + 16 * d0);
        int pos = U.tq0 + 32 * qb + r32; asm volatile("" : "+v"(pos));
        if constexpr (MODE == 1) {
#pragma unroll
            for (int d0 = 0; d0 < ND; ++d0) qf[qb][d0] = __builtin_bit_cast(bf16x8, raw[d0]);
        } else if constexpr (MODE == 0) {
            float v[4][8]; float ss = 0.f;
#pragma unroll
            for (int d0 = 0; d0 < 4; ++d0)
#pragma unroll
                for (int j = 0; j < 4; ++j) { const unsigned w = raw[d0][j]; v[d0][2 * j] = bflo(w); v[d0][2 * j + 1] = bfhi(w); ss += v[d0][2 * j] * v[d0][2 * j] + v[d0][2 * j + 1] * v[d0][2 * j + 1]; }
            ss = pairsum(ss);
            const float rstd = rsqrtf(ss * (1.0f / 64.0f) + EPSN) * C2_64;
#pragma unroll
            for (int d0 = 0; d0 < 4; ++d0)
#pragma unroll
                for (int j = 0; j < 8; ++j) v[d0][j] *= rstd * U.gain[16 * d0 + 8 * hi + j];
            const int row = pos >> 6, col = pos & 63;
#pragma unroll
            for (int j = 0; j < 8; ++j) {
                __builtin_amdgcn_sched_barrier(0);
                const float fi = hi ? invf_c(8 + j) : invf_c(j); float c, s;
                rope_cs(row, fi, c, s); { const float x1 = v[0][j], x2 = v[1][j]; v[0][j] = x1 * c - x2 * s; v[1][j] = x2 * c + x1 * s; }
                rope_cs(col, fi, c, s); { const float x1 = v[2][j], x2 = v[3][j]; v[2][j] = x1 * c - x2 * s; v[3][j] = x2 * c + x1 * s; }
            }
#pragma unroll
            for (int d0 = 0; d0 < 4; ++d0) { u32x4 w; w.x = pk(v[d0][0], v[d0][1]); w.y = pk(v[d0][2], v[d0][3]); w.z = pk(v[d0][4], v[d0][5]); w.w = pk(v[d0][6], v[d0][7]); qf[qb][d0] = __builtin_bit_cast(bf16x8, w); }
        } else {
#pragma unroll
            for (int d0 = 0; d0 < 4; ++d0) qf[qb][d0] = __builtin_bit_cast(bf16x8, raw[d0]);
            float a[8], b[8];
#pragma unroll
            for (int j = 0; j < 4; ++j) { a[2 * j] = bflo(raw[ND - 2][j]); a[2 * j + 1] = bfhi(raw[ND - 2][j]); b[2 * j] = bflo(raw[ND - 1][j]); b[2 * j + 1] = bfhi(raw[ND - 1][j]); }
#pragma unroll
            for (int j = 0; j < 8; ++j) { __builtin_amdgcn_sched_barrier(0); const float fi = hi ? invf_c(8 + j) : invf_c(j); float c, s; rope_cs(pos, fi, c, s);
                const float x1 = a[j], x2 = b[j]; a[j] = x1 * c - x2 * s; b[j] = x2 * c + x1 * s; }
            u32x4 wa, wb; wa.x = pk(a[0], a[1]); wa.y = pk(a[2], a[3]); wa.z = pk(a[4], a[5]); wa.w = pk(a[6], a[7]); wb.x = pk(b[0], b[1]); wb.y = pk(b[2], b[3]); wb.z = pk(b[4], b[5]); wb.w = pk(b[6], b[7]);
            qf[qb][ND - 2] = __builtin_bit_cast(bf16x8, wa); qf[qb][ND - 1] = __builtin_bit_cast(bf16x8, wb);
        }
    }
}

__device__ __forceinline__ float fadd_s(float a, float b) { float r; asm("v_add_f32_e32 %0, %1, %2" : "=v"(r) : "v"(a), "v"(b)); return r; }
__device__ __forceinline__ float fsub_s(float a, float b) { float r; asm("v_sub_f32_e32 %0, %1, %2" : "=v"(r) : "v"(a), "v"(b)); return r; }
#define MFMA32(a, b, c) __builtin_amdgcn_mfma_f32_32x32x16_bf16(a, b, c, 0, 0, 0)
#define SBAR() __builtin_amdgcn_sched_barrier(0)
#define MX3(a, b, c) __builtin_fmaxf(__builtin_fmaxf((a), (b)), (c))

template <int MODE, bool FAST> __device__ __forceinline__ bool attn_unit(LAS unsigned char* lds, const AttU& U, const int wv) {
    constexpr int DK = (MODE == 2) ? 96 : 64, ND = DK / 16, KSTR = (MODE == 2) ? 208 : 144, VSTR = 144;
    constexpr int KP = MODE == 0 ? 128 : (MODE == 1 ? 1536 : 1024), VTS = MODE == 2 ? 65536 : 8192;
    constexpr int STG = 64 * KSTR + 64 * VSTR;
    constexpr float THR = 8.0f;
    int tid_; asm volatile("v_mbcnt_lo_u32_b32 %0, -1, 0\n\tv_mbcnt_hi_u32_b32 %0, -1, %0" : "=v"(tid_)); tid_ += wv * 64;
    const int tid = tid_, lane = tid & 63, r32 = lane & 31, hi = lane >> 5;
    bf16x8 qf[2][ND];
    load_q<MODE>(qf, U, lane);
    f32x16 o[2][2];
#pragma unroll
    for (int a = 0; a < 2; ++a)
#pragma unroll
        for (int b = 0; b < 2; ++b)
#pragma unroll
            for (int r = 0; r < 16; ++r) o[a][b][r] = 0.f;
    float mref[2], lsum[2]; bf16x8 qx[2]; bool bad_ = false;
    const bf16x8 kones = __builtin_bit_cast(bf16x8, (u32x4){hi == 0 ? 0x3f80u : 0u, 0u, 0u, 0u});
    { const unsigned wb0 = (MODE == 1 && !FAST) ? (pk(-U.sink2, 0.f) & 0xffffu) : 0u; const float m0 = -__uint_as_float(wb0 << 16);
      mref[0] = mref[1] = m0; qx[0] = __builtin_bit_cast(bf16x8, (u32x4){hi == 0 ? wb0 : 0u, 0u, 0u, 0u}); qx[1] = qx[0];
      lsum[0] = lsum[1] = (MODE == 1 && hi == 0) ? __builtin_amdgcn_exp2f(U.sink2 - m0) : 0.f; }
    const int krow = tid >> 3, kc = tid & 7;
    const unsigned kgo = (unsigned)(krow * KP + kc * 8) * 2u, krgo = (unsigned)(krow * 32 + kc * 4) * 2u, vgo = (unsigned)tid * 16u;
    const unsigned kdst = krow * KSTR + kc * 16, krdst = krow * KSTR + 128 + kc * 8, vdst = 64 * KSTR + krow * VSTR + kc * 16;
    u32x4 rk, rv, rk2, rv2; u32x2 rr = {0u, 0u}, rr2 = {0u, 0u};
#define ATT_LOADS(RK, RR, RV, tt) do { RK = *(const u32x4*)((const char*)(U.k + (size_t)(tt) * 64 * KP) + kgo); if (MODE == 2) RR = *(const u32x2*)((const char*)(U.kr + (size_t)(tt) * 64 * 32) + krgo); \
        RV = *(const u32x4*)((const char*)(U.vt + (size_t)(tt) * VTS) + vgo); } while (0)
#define ATT_STORES(RK, RR, RV, ss) do { LAS unsigned char* b_ = lds + (ss) * STG; *(LAS u32x4*)(b_ + kdst) = RK; if (MODE == 2) *(LAS u32x2*)(b_ + krdst) = RR; *(LAS u32x4*)(b_ + vdst) = RV; } while (0)
#define ATT_LOAD(tt) ATT_LOADS(rk, rr, rv, tt)
#define ATT_STORE(ss) ATT_STORES(rk, rr, rv, ss)
    const int NT = U.kt1 - U.kt0;
    ATT_LOAD(U.kt0); ATT_STORE(0);
    if (NT > 1) { ATT_LOAD(U.kt0 + 1); ATT_STORE(1); }
    if (NT > 2) ATT_LOAD(U.kt0 + 2);
    if constexpr (FAST) { if (NT > 3) ATT_LOADS(rk2, rr2, rv2, U.kt0 + 3); }
    BAR_LDS();
    f32x16 s[2]; bf16x8 pb[2][2];
    const unsigned koff = r32 * KSTR + hi * 16, voff = 64 * KSTR + r32 * VSTR + hi * 16;
#define ATT_QK(Y, sp, kh) do { LAS const unsigned char* kp_ = lds + (sp) * STG + koff + (kh) * 32 * KSTR; \
        if constexpr (FAST) s[Y] = MFMA32(*(LAS const bf16x8*)(kp_), qf[Y][0], (f32x16){0.f}); \
        else { s[Y] = MFMA32(kones, qx[Y], (f32x16){0.f}); s[Y] = MFMA32(*(LAS const bf16x8*)(kp_), qf[Y][0], s[Y]); } \
        _Pragma("unroll") for (int d0 = 1; d0 < ND; ++d0) s[Y] = MFMA32(*(LAS const bf16x8*)(kp_ + d0 * 32), qf[Y][d0], s[Y]); } while (0)
#define ATT_PV(Y, sp, kh) do { LAS const unsigned char* vp_ = lds + (sp) * STG + voff + (kh) * 64; \
        _Pragma("unroll") for (int db = 0; db < 2; ++db) _Pragma("unroll") for (int ks = 0; ks < 2; ++ks) \
            o[Y][db] = MFMA32(*(LAS const bf16x8*)(vp_ + db * 32 * VSTR + ks * 32), pb[Y][ks], o[Y][db]); } while (0)
#define ATT_ROWMAX(X) float rm_ = MX3(s[X][0], s[X][1], s[X][2]); rm_ = MX3(rm_, s[X][3], s[X][4]); rm_ = MX3(rm_, s[X][5], s[X][6]); rm_ = MX3(rm_, s[X][7], s[X][8]); \
        rm_ = MX3(rm_, s[X][9], s[X][10]); rm_ = MX3(rm_, s[X][11], s[X][12]); rm_ = MX3(rm_, s[X][13], s[X][14]); rm_ = __builtin_fmaxf(rm_, s[X][15]); rm_ = pairmax(rm_)
#define ATT_MF(k_) do { if ((k_) == 0) { if constexpr (!FAST) s[Y_] = MFMA32(kones, qx[Y_], (f32x16){0.f}); } \
        else if ((k_) == 1 && FAST) s[Y_] = MFMA32(kf_[0], qf[Y_][0], (f32x16){0.f}); \
        else if ((k_) <= ND) s[Y_] = MFMA32(kf_[(k_) - 1], qf[Y_][(k_) - 1], s[Y_]); \
        else o[Y_][((k_) - ND - 1) >> 1] = MFMA32(vf_[(k_) - ND - 1], pb[Y_][((k_) - ND - 1) & 1], o[Y_][((k_) - ND - 1) >> 1]); } while (0)
#define ATT_PHASE(X, Y, tx, kh_x, force, sp_v, kh_v, sp_k, kh_k) do { constexpr int Y_ = (Y); \
        LAS const unsigned char* vp_ = lds + (sp_v) * STG + voff + (kh_v) * 64; LAS const unsigned char* kp_ = lds + (sp_k) * STG + koff + (kh_k) * 32 * KSTR; \
        bf16x8 vf_[4], kf_[ND]; \
        _Pragma("unroll") for (int i_ = 0; i_ < (ND > 4 ? 3 : ND); ++i_) kf_[i_] = *(LAS const bf16x8*)(kp_ + i_ * 32); \
        if (MODE == 1) { int db_ = U.tq0 + 32 * (X) + r32 - 4 * hi - ((tx) * 64 + (kh_x) * 32); asm volatile("" : "+v"(db_)); \
            _Pragma("unroll") for (int r = 0; r < 16; ++r) { int d = db_ - ((r & 3) + 8 * (r >> 2)); d = d < 0 ? -d : d; s[X][r] = (d <= 128) ? s[X][r] - U.slope2 * (float)d : -INFINITY; } } \
        if (!FAST && (force)) {     \
            ATT_ROWMAX(X); const unsigned wb_ = pk(-(mref[X] + rm_), 0.f) & 0xffffu; \
            const float mn_ = -__uint_as_float(wb_ << 16), dl_ = mn_ - mref[X]; mref[X] = mn_; \
            qx[X] = __builtin_bit_cast(bf16x8, (u32x4){hi == 0 ? wb_ : 0u, 0u, 0u, 0u}); \
            _Pragma("unroll") for (int r = 0; r < 16; ++r) s[X][r] -= dl_; } \
        SBAR(); \
        float ps_ = 0.f; u32x4 w0_, w1_; \
        _Pragma("unroll") for (int g_ = 0; g_ < 8; ++g_) { \
            if (ND > 4 && g_ == 1) { _Pragma("unroll") for (int i_ = 3; i_ < ND; ++i_) kf_[i_] = *(LAS const bf16x8*)(kp_ + i_ * 32); } \
            if (g_ == (ND > 4 ? 4 : 1)) { _Pragma("unroll") for (int i_ = 0; i_ < 4; ++i_) vf_[i_] = *(LAS const bf16x8*)(vp_ + (i_ >> 1) * 32 * VSTR + (i_ & 1) * 32); } \
            ATT_MF(g_); \
            const float a_ = __builtin_amdgcn_exp2f(s[X][2 * g_]), b_ = __builtin_amdgcn_exp2f(s[X][2 * g_ + 1]); \
            ps_ += a_; ps_ += b_; unsigned w_ = pk(a_, b_); asm volatile("" : "+v"(w_), "+v"(ps_)); if (g_ < 4) w0_[g_ & 3] = w_; else w1_[g_ & 3] = w_; \
            SBAR(); } \
        _Pragma("unroll") for (int k_ = 8; k_ < ND + 5; ++k_) ATT_MF(k_); \
        if constexpr (FAST) { bad_ |= (__builtin_amdgcn_ballot_w64(!(ps_ <= 1.0995116e12f) || ((force) && ps_ < 9.3132257e-10f)) != 0ull); } \
        else if (__builtin_amdgcn_ballot_w64(!(ps_ <= 65536.0f)) != 0ull) {     \
            ATT_ROWMAX(X); const float d_ = fmaxf(rm_, 0.f); const unsigned wb_ = pk(-(mref[X] + d_), 0.f) & 0xffffu; \
            const float mn_ = -__uint_as_float(wb_ << 16), dl_ = mn_ - mref[X]; mref[X] = mn_; \
            qx[X] = __builtin_bit_cast(bf16x8, (u32x4){hi == 0 ? wb_ : 0u, 0u, 0u, 0u}); \
            const float f_ = __builtin_amdgcn_exp2f(-dl_); lsum[X] *= f_; _Pragma("unroll") for (int r = 0; r < 16; ++r) { o[X][0][r] *= f_; o[X][1][r] *= f_; } \
            ps_ = 0.f; \
            _Pragma("unroll") for (int g_ = 0; g_ < 8; ++g_) { s[X][2 * g_] -= dl_; s[X][2 * g_ + 1] -= dl_; \
                const float a_ = __builtin_amdgcn_exp2f(s[X][2 * g_]), b_ = __builtin_amdgcn_exp2f(s[X][2 * g_ + 1]); ps_ += a_; ps_ += b_; \
                const unsigned w_ = pk(a_, b_); if (g_ < 4) w0_[g_ & 3] = w_; else w1_[g_ & 3] = w_; } } \
        lsum[X] += ps_; pb[X][0] = __builtin_bit_cast(bf16x8, w0_); pb[X][1] = __builtin_bit_cast(bf16x8, w1_); SBAR(); } while (0)

    pb[1][0] = (bf16x8){0, 0, 0, 0, 0, 0, 0, 0}; pb[1][1] = pb[1][0];
    ATT_QK(0, 0, 0);
#define ATT_TILE(tt, DIST, RK, RR, RV) do { const int t = (tt); \
        const int j = t - U.kt0, sc = j & 3, sp = (j == 0) ? 0 : ((j + 3) & 3), sn = (j + 1) & 3; \
        if (j + 2 < NT) ATT_STORES(RK, RR, RV, (j + 2) & 3); \
        if (j + (DIST) < NT) ATT_LOADS(RK, RR, RV, t + (DIST)); \
        const bool f0 = (MODE != 1) && (j == 0); \
        ATT_PHASE(0, 1, t, 0, f0, sp, 1, sc, 0); \
        ATT_PHASE(1, 0, t, 0, f0, sc, 0, sc, 1); \
        ATT_PHASE(0, 1, t, 1, false, sc, 0, sc, 1); \
        ATT_PHASE(1, 0, t, 1, false, sc, 1, sn, 0); \
        BAR_LDS(); } while (0)
    if constexpr (FAST) {
        for (int t2 = U.kt0; t2 < U.kt1; t2 += 2) { ATT_TILE(t2, 4, rk, rr, rv); ATT_TILE(t2 + 1, 4, rk2, rr2, rv2); }
    } else {
        for (int t1 = U.kt0; t1 < U.kt1; ++t1) ATT_TILE(t1, 3, rk, rr, rv);
    }
    ATT_PV(1, (NT - 1) & 3, 1);
    BAR_LDS();
#undef ATT_LOAD
#undef ATT_LOADS
#undef ATT_STORES
#undef ATT_TILE
#undef ATT_STORE
#undef ATT_QK
#undef ATT_PV
#undef ATT_PHASE
#undef ATT_MF
#undef ATT_ROWMAX
    if constexpr (FAST) {
        volatile LAS unsigned* vote = (volatile LAS unsigned*)(lds + 131072 + 64);
        if (lane == 0) vote[wv] = bad_ ? 1u : 0u;
        BAR_LDS();
        const unsigned any_ = vote[0] | vote[1] | vote[2] | vote[3] | vote[4] | vote[5] | vote[6] | vote[7];
        BAR_LDS();
        if (any_) return true;
    }
#pragma unroll
    for (int qb = 0; qb < 2; ++qb) {
        const float inv = 1.0f / pairsum(lsum[qb]);
        bf16_t* op = U.o + (size_t)(32 * qb + r32) * DM + 8 * hi;
#pragma unroll
        for (int db = 0; db < 2; ++db)
#pragma unroll
            for (int k = 0; k < 2; ++k) {
                const int ga = 2 * k, gb = 2 * k + 1;
                const unsigned ax = pk(o[qb][db][4 * ga] * inv, o[qb][db][4 * ga + 1] * inv), ay = pk(o[qb][db][4 * ga + 2] * inv, o[qb][db][4 * ga + 3] * inv);
                const unsigned bx = pk(o[qb][db][4 * gb] * inv, o[qb][db][4 * gb + 1] * inv), by = pk(o[qb][db][4 * gb + 2] * inv, o[qb][db][4 * gb + 3] * inv);
                auto rx = __builtin_amdgcn_permlane32_swap(ax, bx, false, false); auto ry = __builtin_amdgcn_permlane32_swap(ay, by, false, false);
                u32x4 w; w.x = rx[0]; w.y = ry[0]; w.z = rx[1]; w.w = ry[1];
                *(u32x4*)(op + 32 * db + 16 * k) = w; }
    }
    return false;
}

__device__ __forceinline__ void rms_row_bf16(const float* xrow, bf16_t* orow, int lane) {
    const f32x4* xr = (const f32x4*)xrow + lane; f32x4 v[4]; float s = 0.f;
#pragma unroll
    for (int j = 0; j < 4; ++j) { v[j] = xr[64 * j]; s += (v[j].x * v[j].x + v[j].y * v[j].y) + (v[j].z * v[j].z + v[j].w * v[j].w); }
    const float rstd = rsqrtf(wave_sum(s) * (1.0f / DM) + EPSN);
    u32x2* o8 = (u32x2*)orow + lane;
#pragma unroll
    for (int j = 0; j < 4; ++j) { u32x2 w; w.x = pk(v[j].x * rstd, v[j].y * rstd); w.y = pk(v[j].z * rstd, v[j].w * rstd); o8[64 * j] = w; }
}
__device__ __forceinline__ void rms_row_final(float* xrow, const float* g, int lane) {
    f32x4* xr = (f32x4*)xrow + lane; const f32x4* gr = (const f32x4*)g + lane; f32x4 v[4]; float s = 0.f;
#pragma unroll
    for (int j = 0; j < 4; ++j) { v[j] = xr[64 * j]; s += (v[j].x * v[j].x + v[j].y * v[j].y) + (v[j].z * v[j].z + v[j].w * v[j].w); }
    const float rstd = rsqrtf(wave_sum(s) * (1.0f / DM) + EPSN);
#pragma unroll
    for (int j = 0; j < 4; ++j) xr[64 * j] = v[j] * rstd * gr[64 * j];
}
struct WDesc { const float* W; int K, Nsrc, Nout; bf16_t* WT; const float* kgain; int mode; };
__device__ __forceinline__ void wprep_item(const WDesc& D, LAS float* scr, int item, int lane) {
    const int nblk = D.Nout / 32, kb = item / nblk, nb = item % nblk, k0 = 64 * kb, n0 = 32 * nb;
    int src0 = n0; float cs = 1.f;
    if (D.mode == 1) { if (n0 >= 768 && n0 < 1280) cs = C2_64; }
    else if (D.mode == 2) { if (n0 >= D.Nsrc) src0 = -1; }
    else if (D.mode == 3) cs = C2_96;
    else if (D.mode == 4) { src0 = (n0 < 1024) ? (n0 >> 6) * 128 + (n0 & 63) : ((n0 - 1024) >> 6) * 128 + 64 + (n0 & 63); }
    else if (D.mode == 5) { const int pn = n0 >> 8, j = n0 & 255; src0 = (j < 128) ? 128 * pn + j : 2816 + 128 * pn + (j - 128); }
#pragma unroll 8
    for (int i = 0; i < 32; ++i) { const int kk = 2 * i + (lane >> 5);
        float v = 0.f; if (src0 >= 0) { v = D.W[(size_t)(k0 + kk) * D.Nsrc + src0 + (lane & 31)] * cs; if (D.kgain) v *= D.kgain[k0 + kk]; }
        scr[kk * 33 + (lane & 31)] = v; }
    asm volatile("s_waitcnt lgkmcnt(0)" ::: "memory");
    const int c = lane & 7;
#pragma unroll
    for (int j = 0; j < 4; ++j) { const int n = (lane >> 3) + 8 * j; const LAS float* s = scr + (8 * c) * 33 + n;
        u32x4 o; o.x = pk(s[0 * 33], s[1 * 33]); o.y = pk(s[2 * 33], s[3 * 33]); o.z = pk(s[4 * 33], s[5 * 33]); o.w = pk(s[6 * 33], s[7 * 33]);
        *(u32x4*)(D.WT + (size_t)(n0 + n) * D.K + k0 + 8 * c) = o; }
    asm volatile("s_waitcnt lgkmcnt(0)" ::: "memory");
}
__device__ __forceinline__ void transpose_store(LAS unsigned char* wl, const u32x4 (&r)[8], bf16_t* dst, int lane) {
#pragma unroll
    for (int c = 0; c < 8; ++c) *(LAS u32x4*)(wl + lane * 144 + 16 * c) = r[c];
    asm volatile("s_waitcnt lgkmcnt(0)" ::: "memory");
    unsigned w[32];
#pragma unroll
    for (int pp = 0; pp < 32; ++pp) {
        const int p0 = 2 * pp, p1 = 2 * pp + 1;
        const int q0 = (p0 & 15) >> 2, q1 = (p1 & 15) >> 2;
        const int t0 = 16 * (p0 >> 4) + 4 * (q0 == 1 ? 2 : (q0 == 2 ? 1 : q0)) + (p0 & 3), t1 = 16 * (p1 >> 4) + 4 * (q1 == 1 ? 2 : (q1 == 2 ? 1 : q1)) + (p1 & 3);
        const unsigned lo = *(LAS const unsigned short*)(wl + t0 * 144 + 2 * lane), hi = *(LAS const unsigned short*)(wl + t1 * 144 + 2 * lane);
        w[pp] = lo | (hi << 16);
    }
#pragma unroll
    for (int c = 0; c < 8; ++c) { u32x4 o; o.x = w[4 * c]; o.y = w[4 * c + 1]; o.z = w[4 * c + 2]; o.w = w[4 * c + 3]; *(u32x4*)(dst + lane * 64 + 8 * c) = o; }
    asm volatile("s_waitcnt lgkmcnt(0)" ::: "memory");
}

#define XB_TMO      128
#define XB_XCNT(j)  (256  + 64 * (j))
#define XB_XSUB(j)  (1280 + 64 * (j))
#define XB_XGEN(j)  (2304 + 64 * (j))
#define XB_TOP      3328
#define XB_TOPGEN   3392
#define XCD_BAR_WORDS 3456
#define XB_SPIN_CAP (1u << 18)

__device__ __forceinline__ unsigned xb_ld(unsigned* p)              { return __hip_atomic_load(p, __ATOMIC_RELAXED, __HIP_MEMORY_SCOPE_AGENT); }
__device__ __forceinline__ unsigned xb_add(unsigned* p, unsigned v) { return __hip_atomic_fetch_add(p, v, __ATOMIC_RELAXED, __HIP_MEMORY_SCOPE_AGENT); }
__device__ __forceinline__ unsigned xb_xcc_id() { return (unsigned)__builtin_amdgcn_s_getreg((3 << 11) | 20) & 0xFu; }
#define XB_SPIN(cond, bar) do { unsigned _sp = 0; while (cond) { __builtin_amdgcn_s_sleep(1); \
    if ((++_sp & 255u) == 0u) { if (xb_ld(&(bar)[XB_TMO])) break; if (_sp > XB_SPIN_CAP) { atomicAdd(&(bar)[XB_TMO], 1u); break; } } } } while (0)

struct XcdBarrier { unsigned* bar; unsigned x; volatile LAS unsigned* st; };
__device__ __forceinline__ void xcd_barrier_complete(unsigned* bar, unsigned x, unsigned& nloc, unsigned& nx) {
    const unsigned G = gridDim.x * gridDim.y * gridDim.z;
    unsigned sum, cnt, mine, sp = 0u;
    for (;;) {
        sum = 0u; cnt = 0u; mine = 0u;
#pragma unroll
        for (unsigned j = 0; j < 16; ++j) { const unsigned c = xb_ld(&bar[XB_XCNT(j)]); sum += c; cnt += (c > 0u) ? 1u : 0u; mine = (j == x) ? c : mine; }
        if (sum == G) break;
        __builtin_amdgcn_s_sleep(1);
        if ((++sp & 255u) == 0u) { if (xb_ld(&bar[XB_TMO])) break; if (sp > XB_SPIN_CAP) { atomicAdd(&bar[XB_TMO], 1u); break; } }
    }
    nloc = mine > 0u ? mine : 1u; nx = cnt > 0u ? cnt : 1u;
}

__device__ __forceinline__ void xcd_barrier(const XcdBarrier& b, const bool is_t0) {
    asm volatile("s_waitcnt vmcnt(0)" ::: "memory");
    __syncthreads();
    if (is_t0) {
        unsigned* bar = b.bar;
        __builtin_amdgcn_s_waitcnt(0);
        unsigned nloc = b.st[0], nx = b.st[1];
        if (nloc == 0u) { xcd_barrier_complete(bar, b.x, nloc, nx); b.st[0] = nloc; b.st[1] = nx; }
        const unsigned old = xb_add(&bar[XB_XSUB(b.x)], 1u);
        const unsigned gen = old / nloc;
        if (old + 1u == (gen + 1u) * nloc) {
            __builtin_amdgcn_fence(__ATOMIC_RELEASE, "agent");
            asm volatile("s_waitcnt vmcnt(0)" ::: "memory");
            const unsigned og = xb_add(&bar[XB_TOP], 1u);
            const unsigned tg = og / nx;
            if (og + 1u == (tg + 1u) * nx) xb_add(&bar[XB_TOPGEN], 1u);
            else XB_SPIN(xb_ld(&bar[XB_TOPGEN]) == tg, bar);
            __builtin_amdgcn_fence(__ATOMIC_ACQUIRE, "agent");
            xb_add(&bar[XB_XGEN(b.x)], 1u);
            asm volatile("s_waitcnt vmcnt(0)" ::: "memory");
        } else {
            XB_SPIN(xb_ld(&bar[XB_XGEN(b.x)]) == gen, bar);
            __builtin_amdgcn_fence(__ATOMIC_ACQUIRE, "agent");
            asm volatile("s_waitcnt vmcnt(0)" ::: "memory");
        }
    }
    __syncthreads();
}

constexpr size_t MiB = 1u << 20;
constexpr size_t WS_WIN0 = 0, WS_WOUT0 = 3 * MiB, WS_WDN = 5 * MiB, WS_WUQ = 7 * MiB, WS_WUKV = 9 * MiB, WS_WOUT1 = 10 * MiB, WS_WUP0 = 12 * MiB, WS_WUP1 = 23 * MiB,
                 WS_WDOWN0 = 34 * MiB, WS_WDOWN1 = 40 * MiB, WS_KROPE = 46 * MiB, WS_BAR = 49 * MiB, WS_ROWSS = 49 * MiB + 65536;
constexpr size_t WS_H = 50 * MiB + 4096;
constexpr size_t WS_CKVN = 50 * MiB + 4096 + 40 * MiB;
constexpr size_t WS_A = 147 * MiB;
constexpr size_t WS_B = 291 * MiB;
constexpr size_t WS_KA = WS_B, WS_VAT = WS_B + 12 * MiB, WS_VBT = WS_B + 24 * MiB;
constexpr size_t WS_KNOPE = WS_B, WS_VRAW = WS_B + 96 * MiB;
constexpr size_t WS_HA = WS_A;
constexpr size_t WS_HID = WS_A + 97 * MiB;
constexpr size_t WS_END = 508 * MiB;

struct Args { const float* in[20]; float* out_; unsigned char* ws_; };
#ifndef PHM
#define PHM 0xFFFFFFFFu
#endif
#define PH(k) ((PHM >> (k)) & 1u)
#ifndef REP_THIN
#define REP_THIN 1
#endif
#ifndef REP_UP
#define REP_UP 1
#endif
#ifndef REP_L0
#define REP_L0 1
#endif
#ifndef REP_MLA
#define REP_MLA 1
#endif

__global__ void __launch_bounds__(512) fwd_megakernel(Args a) {
    extern __shared__ __attribute__((aligned(16))) unsigned char lds_raw[];
    cg::grid_group grid = cg::this_grid();
    LAS unsigned char* lds = (LAS unsigned char*)lds_raw;
    int tid, lane, gw; const __attribute__((address_space(4))) Args* ap;
#define ws (ap->ws_)
#define out (ap->out_)
#define xp (ap->in[0])
#define xs (ap->in[1])
#define Hb ((bf16_t*)(ap->ws_ + WS_H))
#define QKV0 ((bf16_t*)(ap->ws_ + WS_A))
    const int wave = __builtin_amdgcn_readfirstlane(threadIdx.x >> 6);
    const int G = gridDim.x, bx = blockIdx.x, NGW = G * 8;
#define REFRESH() do { asm volatile("v_mbcnt_lo_u32_b32 %0, -1, 0\n\tv_mbcnt_hi_u32_b32 %0, -1, %0" : "=v"(lane)); tid = wave * 64 + lane; gw = bx * 8 + wave; ap = (const __attribute__((address_space(4))) Args*)__builtin_amdgcn_kernarg_segment_ptr(); asm volatile("" : "+s"(ap)); } while (0)
    REFRESH();
    volatile LAS unsigned* xb_st = (volatile LAS unsigned*)(lds + 131072);
    if (threadIdx.x < 2) xb_st[threadIdx.x] = 0u;
    __syncthreads();
#define GRID_BAR() do { REFRESH(); XcdBarrier xb_; xb_.bar = (unsigned*)(ap->ws_ + WS_BAR); xb_.x = xb_xcc_id(); xb_.st = xb_st; xcd_barrier(xb_, tid == 0); REFRESH(); } while (0)
#define xcd_ok (gridDim.x == 256u)
#define xcd ((int)(blockIdx.x & 7u))
#define slot ((int)(blockIdx.x >> 3))

    _Pragma("nounroll") for (int rt_ = 0; rt_ < REP_THIN; ++rt_) if (PH(0)) {
        LAS float* scr = (LAS float*)(lds + wave * 16384);
        WDesc D[10];
        D[0] = WDesc{ap->in[5], 1024, 1536, 1536, (bf16_t*)(ws + WS_WIN0), ap->in[2], 1};
        D[1] = WDesc{ap->in[9], 1024, 1024, 1024, (bf16_t*)(ws + WS_WOUT0), nullptr, 0};
        D[2] = WDesc{ap->in[10], 1024, 672, 768, (bf16_t*)(ws + WS_WDN), ap->in[2] + 1024, 2};
        D[3] = WDesc{ap->in[13], 384, 1536, 1536, (bf16_t*)(ws + WS_WUQ), ap->in[11], 3};
        D[4] = WDesc{ap->in[14], 256, 2048, 2048, (bf16_t*)(ws + WS_WUKV), ap->in[12], 4};
        D[5] = WDesc{ap->in[15], 1024, 1024, 1024, (bf16_t*)(ws + WS_WOUT1), nullptr, 0};
        D[6] = WDesc{ap->in[16], 1024, 5632, 5632, (bf16_t*)(ws + WS_WUP0), ap->in[3], 5};
        D[7] = WDesc{ap->in[16] + (size_t)1024 * 5632, 1024, 5632, 5632, (bf16_t*)(ws + WS_WUP1), ap->in[3] + 1024, 5};
        D[8] = WDesc{ap->in[19], 2816, 1024, 1024, (bf16_t*)(ws + WS_WDOWN0), nullptr, 0};
        D[9] = WDesc{ap->in[19] + (size_t)2816 * 1024, 2816, 1024, 1024, (bf16_t*)(ws + WS_WDOWN1), nullptr, 0};
        int base = 0;
#pragma unroll
        for (int m = 0; m < 10; ++m) {
            const int ni = (D[m].K / 64) * (D[m].Nout / 32);
            int first = gw - (base % NGW); if (first < 0) first += NGW;
            for (int it = first; it < ni; it += NGW) wprep_item(D[m], scr, it, lane);
            base += ni;
        }
        for (int i = bx * 512 + tid; i < 3 * T; i += G * 512) ((float*)(ap->ws_ + WS_ROWSS))[i] = 0.f;
        if (bx == 0) for (int i = tid; i < XCD_BAR_WORDS; i += 512) ((unsigned*)(ap->ws_ + WS_BAR))[i] = 0u;
        for (int m = gw, it_ = 0; it_ < T / 2048; ++it_, m += 2048) rms_row_bf16(m < SEQ ? xp + (size_t)m * DM : xs + (size_t)(m - SEQ) * DM, Hb + (size_t)m * DM, lane);
    }
    grid.sync(); REFRESH();
    if (tid == 0) (void)xb_add(&((unsigned*)(ap->ws_ + WS_BAR))[XB_XCNT(xb_xcc_id())], 1u);

    if (PH(1)) {
        pg8::Gemm g{Hb, (const bf16_t*)(ws + WS_WIN0), T, 1536, 1024}; pg8::StaticOrder S; S.init(T, 1536, G, bx);
        pg8::EpiBf16 E{QKV0, 1536, 0, 0, nullptr};
        pg8::gemm_phase<pg8::EpiBf16, pg8::StaticOrder, true, true>(lds, g, S, E, wave);
    }
    GRID_BAR();
    _Pragma("nounroll") for (int rt_ = 0; rt_ < REP_THIN; ++rt_) if (PH(2)) {
        LAS unsigned char* wl = lds + wave * 9216;
        bf16_t* KA = (bf16_t*)(ws + WS_KA);
        for (int it = gw; it < 768 * 6; it += NGW) {
            const int tl = it / 6, job = it % 6; const int tok = tl * 64 + lane;
            if (job < 4) {
                const int hh = job & 1, isb = job >> 1;
                const bf16_t* src = QKV0 + (size_t)tok * 1536 + (isb ? 1408 : 640) + 64 * hh;
                u32x4 r[8];
#pragma unroll
                for (int c = 0; c < 8; ++c) r[c] = *(const u32x4*)(src + 8 * c);
                bf16_t* dst = (bf16_t*)(ws + (isb ? WS_VBT : WS_VAT)) + ((size_t)tl * 2 + hh) * 4096;
                transpose_store(wl, r, dst, lane);
            } else {
                const int hh = job - 4;
                const bf16_t* src = QKV0 + (size_t)tok * 1536 + 512 + 64 * hh;
                float v[64]; float ss = 0.f;
#pragma unroll
                for (int c = 0; c < 8; ++c) { const u32x4 w = *(const u32x4*)(src + 8 * c);
#pragma unroll
                    for (int j = 0; j < 4; ++j) { v[8 * c + 2 * j] = bflo(w[j]); v[8 * c + 2 * j + 1] = bfhi(w[j]); } }
#pragma unroll
                for (int d = 0; d < 64; ++d) ss += v[d] * v[d];
                const float rstd = rsqrtf(ss * (1.0f / 64.0f) + EPSN);
                const float* kg = ap->in[7];
#pragma unroll
                for (int d = 0; d < 64; ++d) v[d] *= rstd * kg[d];
                int pos = tok & (SEQ - 1); asm volatile("" : "+v"(pos)); const int row = pos >> 6, col = pos & 63;
#pragma unroll
                for (int i = 0; i < 16; ++i) { float c, s;
                    rope_cs(row, invf_c(i), c, s); { const float x1 = v[i], x2 = v[16 + i]; v[i] = x1 * c - x2 * s; v[16 + i] = x2 * c + x1 * s; }
                    rope_cs(col, invf_c(i), c, s); { const float x1 = v[32 + i], x2 = v[48 + i]; v[32 + i] = x1 * c - x2 * s; v[48 + i] = x2 * c + x1 * s; } }
                bf16_t* dst = KA + (size_t)tok * 128 + 64 * hh;
#pragma unroll
                for (int c = 0; c < 8; ++c) { u32x4 w; w.x = pk(v[8 * c], v[8 * c + 1]); w.y = pk(v[8 * c + 2], v[8 * c + 3]); w.z = pk(v[8 * c + 4], v[8 * c + 5]); w.w = pk(v[8 * c + 6], v[8 * c + 7]); *(u32x4*)(dst + 8 * c) = w; }
            }
        }
    }
    GRID_BAR();
    if (PH(3)) {
#define L0_UNITS(CALL0, CALL1) \
        for (int pass = 0; pass < 2; ++pass) \
            for (int i_ = 0; i_ < 3 * REP_L0; ++i_) { const int i = i_ % 3; const unsigned ubit = 1u << (3 * pass + i); \
                const int unit = 96 * xcd + 32 * i + slot; \
                const int combo = unit >> 7, qb = unit & 127, sq = combo >> 1, kvh = combo & 1; \
                const int head = 4 * kvh + (wave >> 1), tq0 = 128 * qb + 64 * (wave & 1); \
                const size_t row0 = (size_t)sq * SEQ; \
                AttU U; \
                U.kr = nullptr; U.gain = ap->in[6]; U.tq0 = tq0; \
                U.o = Hb + (row0 + tq0) * DM + (pass ? 512 : 0) + 64 * head; \
                if (pass == 0) { \
                    U.q = QKV0 + (row0 + tq0) * 1536 + 64 * head; \
                    U.k = (const bf16_t*)(ws + WS_KA) + row0 * 128 + 64 * kvh; \
                    U.vt = (const bf16_t*)(ws + WS_VAT) + ((size_t)sq * 256 * 2 + kvh) * 4096; \
                    U.kt0 = 0; U.kt1 = 256; U.slope2 = 0.f; U.sink2 = 0.f; \
                    if (PH(20)) { CALL0; } \
                } else { \
                    U.q = QKV0 + (row0 + tq0) * 1536 + 768 + 64 * head; \
                    U.k = QKV0 + row0 * 1536 + 1280 + 64 * kvh; \
                    U.vt = (const bf16_t*)(ws + WS_VBT) + ((size_t)sq * 256 * 2 + kvh) * 4096; \
                    U.kt0 = qb > 0 ? 2 * (qb - 1) : 0; U.kt1 = qb < 127 ? 2 * (qb + 2) : 256; \
                    U.slope2 = LOG2E * exp2f(-(float)(head + 1)); U.sink2 = LOG2E * ap->in[8][head]; \
                    if (PH(21)) { CALL1; } \
                } \
            }
        unsigned badmask = 0u;
        L0_UNITS(if ((attn_unit<0, true>(lds, U, wave))) badmask |= ubit, if ((attn_unit<1, true>(lds, U, wave))) badmask |= ubit)
        if (badmask) {
            L0_UNITS(if (badmask & ubit) (void)(attn_unit<0, false>(lds, U, wave)), if (badmask & ubit) (void)(attn_unit<1, false>(lds, U, wave))) }
#undef L0_UNITS
    }
    GRID_BAR();
    if (PH(4)) {
        pg8::Gemm g{Hb, (const bf16_t*)(ws + WS_WOUT0), T, 1024, 1024}; pg8::StaticOrder S; S.init(T, 1024, G, bx);
        pg8::EpiResT<false> E{xp, xs, SEQ, nullptr, nullptr, DM, (bf16_t*)(ws + WS_HA), (float*)(ws + WS_ROWSS)};
        pg8::gemm_phase<pg8::EpiResT<false>, pg8::StaticOrder, true, true>(lds, g, S, E, wave);
    }
    GRID_BAR();

    _Pragma("unroll") for (int layer = 0; layer < 2; ++layer) {
        if (layer == 1) {
            bf16_t* CDOWN = (bf16_t*)(ws + WS_B);
            if (PH(9)) {
                pg8::Gemm g{(const bf16_t*)out  , (const bf16_t*)(ws + WS_WDN), T, 768, 1024}; pg8::StaticOrder S; S.init(T, 768, G, bx);
                pg8::EpiBf16 E{CDOWN, 768, 0, 0, (const float*)(ws + WS_ROWSS) + T};
                pg8::gemm_phase<pg8::EpiBf16, pg8::StaticOrder, true, true>(lds, g, S, E, wave);
            }
            GRID_BAR();
            bf16_t* CQN = Hb; bf16_t* CKVN = (bf16_t*)(ws + WS_CKVN); bf16_t* KROPE = (bf16_t*)(ws + WS_KROPE);
            _Pragma("nounroll") for (int rt_ = 0; rt_ < REP_THIN; ++rt_) if (PH(10)) for (int m = gw, it_ = 0; it_ < T / 2048; ++it_, m += 2048) {
                const bf16_t* row = CDOWN + (size_t)m * 768;
                const unsigned* pq = (const unsigned*)row + 3 * lane; const unsigned* pkv = (const unsigned*)(row + 384) + 2 * lane;
                const unsigned q0 = pq[0], q1 = pq[1], q2 = pq[2], k0 = pkv[0], k1 = pkv[1];
                float sq_ = bflo(q0) * bflo(q0) + bfhi(q0) * bfhi(q0) + bflo(q1) * bflo(q1) + bfhi(q1) * bfhi(q1) + bflo(q2) * bflo(q2) + bfhi(q2) * bfhi(q2);
                float sk_ = bflo(k0) * bflo(k0) + bfhi(k0) * bfhi(k0) + bflo(k1) * bflo(k1) + bfhi(k1) * bfhi(k1);
                const float rq = rsqrtf(wave_sum(sq_) * (1.0f / 384.0f) + EPSN), rk = rsqrtf(wave_sum(sk_) * (1.0f / 256.0f) + EPSN);
                unsigned* oq = (unsigned*)(CQN + (size_t)m * 384) + 3 * lane; unsigned* ok = (unsigned*)(CKVN + (size_t)m * 256) + 2 * lane;
                oq[0] = pk(bflo(q0) * rq, bfhi(q0) * rq); oq[1] = pk(bflo(q1) * rq, bfhi(q1) * rq); oq[2] = pk(bflo(q2) * rq, bfhi(q2) * rq);
                ok[0] = pk(bflo(k0) * rk, bfhi(k0) * rk); ok[1] = pk(bflo(k1) * rk, bfhi(k1) * rk);
                if (lane < 16) { const float x1 = __uint_as_float((unsigned)row[640 + lane] << 16), x2 = __uint_as_float((unsigned)row[656 + lane] << 16);
                    float c, s; rope_cs(m & (SEQ - 1), INVF_TAB[lane], c, s);
                    const unsigned w = pk(x1 * c - x2 * s, x2 * c + x1 * s);
                    KROPE[(size_t)m * 32 + lane] = (bf16_t)(w & 0xffffu); KROPE[(size_t)m * 32 + 16 + lane] = (bf16_t)(w >> 16); }
            }
            GRID_BAR();
            bf16_t* QRAW = (bf16_t*)(ws + WS_A);
            if (PH(11)) {
                { pg8::Gemm g{CQN, (const bf16_t*)(ws + WS_WUQ), T, 1536, 384}; pg8::StaticOrder S; S.init(T, 1536, G, bx);
                  pg8::EpiBf16 E{QRAW, 1536, 0, 0, nullptr};
                  pg8::gemm_phase<pg8::EpiBf16, pg8::StaticOrder, true, true>(lds, g, S, E, wave); }
                { pg8::Gemm g{CKVN, (const bf16_t*)(ws + WS_WUKV), T, 2048, 256}; pg8::StaticOrder S; S.init(T, 2048, G, bx);
                  pg8::EpiBf16 E{(bf16_t*)(ws + WS_KNOPE), 1024, 1024, (WS_VRAW - WS_KNOPE) / 2, nullptr};
                  pg8::gemm_phase<pg8::EpiBf16, pg8::StaticOrder, true, true>(lds, g, S, E, wave); }
            }
            GRID_BAR();
            if (PH(12)) {
                LAS unsigned char* wl = lds + wave * 9216;
                bf16_t* VR = (bf16_t*)(ws + WS_VRAW);
                for (int tl = bx; tl < 768; tl += G) {
                    const bf16_t* src = VR + ((size_t)tl * 64 + lane) * 1024;
                    u32x4 r0[8], r1[8];
#pragma unroll
                    for (int c = 0; c < 8; ++c) { r0[c] = *(const u32x4*)(src + 64 * wave + 8 * c); r1[c] = *(const u32x4*)(src + 64 * (wave + 8) + 8 * c); }
                    asm volatile("s_waitcnt vmcnt(0)" ::: "memory");
                    __syncthreads();
                    transpose_store(wl, r0, VR + ((size_t)tl * 16 + wave) * 4096, lane);
                    transpose_store(wl, r1, VR + ((size_t)tl * 16 + wave + 8) * 4096, lane);
                }
            }
            GRID_BAR();
            if (PH(13)) {
#define L1_UNITS(CALL) \
                for (int i_ = 0; i_ < 6 * REP_MLA; ++i_) { const int i = i_ % 6; const unsigned ubit = 1u << i; \
                    const int combo = xcd * 6 + i, qb = slot; \
                    const int sq = combo >> 4, head = combo & 15, tq0 = 512 * qb + 64 * wave; \
                    const size_t row0 = (size_t)sq * SEQ; \
                    AttU U; \
                    U.q = QRAW + (row0 + tq0) * 1536 + 96 * head; \
                    U.k = (const bf16_t*)(ws + WS_KNOPE) + row0 * 1024 + 64 * head; \
                    U.kr = KROPE + row0 * 32; \
                    U.vt = (const bf16_t*)(ws + WS_VRAW) + ((size_t)sq * 256 * 16 + head) * 4096; \
                    U.o = Hb + (row0 + tq0) * DM + 64 * head; \
                    U.kt0 = 0; U.kt1 = 256; U.tq0 = tq0; U.gain = nullptr; U.slope2 = 0.f; U.sink2 = 0.f; \
                    CALL; \
                }
                unsigned badmask = 0u;
                L1_UNITS(if ((attn_unit<2, true>(lds, U, wave))) badmask |= ubit)
                if (badmask) {
                    L1_UNITS(if (badmask & ubit) (void)(attn_unit<2, false>(lds, U, wave))) }
#undef L1_UNITS
            }
            GRID_BAR();
            if (PH(14)) {
                pg8::Gemm g{Hb, (const bf16_t*)(ws + WS_WOUT1), T, 1024, 1024}; pg8::StaticOrder S; S.init(T, 1024, G, bx);
                pg8::EpiResT<true> E{nullptr, nullptr, 0, (const bf16_t*)out, nullptr, DM, (bf16_t*)(ws + WS_HA), (float*)(ws + WS_ROWSS) + 2 * T};
                pg8::gemm_phase<pg8::EpiResT<true>, pg8::StaticOrder, true, true>(lds, g, S, E, wave);
            }
            GRID_BAR();
        }
        bf16_t* HID = (bf16_t*)(ws + WS_HID);
        _Pragma("nounroll") for (int rep_ = 0; rep_ < REP_UP; ++rep_) if (PH(6)) {
            pg8::Gemm g{(const bf16_t*)(ws + WS_HA), (const bf16_t*)(ws + (layer ? WS_WUP1 : WS_WUP0)), T, 5632, 1024}; pg8::StaticOrder S; S.init_t(3 * pg8::EpiGlu::TPS, 22, G, bx);
            pg8::EpiGlu E{HID, ap->in[17] + (size_t)layer * 3 * FF, ap->in[18] + (size_t)layer * FF, (const float*)(ws + WS_ROWSS) + (size_t)layer * 2 * T};
            pg8::gemm_phase<pg8::EpiGlu, pg8::StaticOrder, true, true>(lds, g, S, E, wave);
        }
        GRID_BAR();
        if (PH(7)) {
            pg8::Gemm g{HID, (const bf16_t*)(ws + (layer ? WS_WDOWN1 : WS_WDOWN0)), T, 1024, 2816}; pg8::StaticOrder S; S.init(T, 1024, G, bx);
            pg8::EpiResT<true> E{nullptr, nullptr, 0, (const bf16_t*)(ws + WS_HA), layer ? out : (float*)nullptr, DM, layer ? (bf16_t*)nullptr : (bf16_t*)out, (float*)(ws + WS_ROWSS) + T};
            pg8::gemm_phase<pg8::EpiResT<true>, pg8::StaticOrder, true, true>(lds, g, S, E, wave);
        }
        GRID_BAR();
    }
    for (int m = gw, it_ = 0; it_ < T / 2048; ++it_, m += 2048) rms_row_final(out + (size_t)m * DM, ap->in[4], lane);
}

#undef ws
#undef out
#undef xp
#undef xs
#undef Hb
#undef QKV0
extern "C" void kernel_launch(void* const* d_in, const int* in_sizes, int n_in, void* d_out, int out_size, void* d_ws, size_t ws_size, hipStream_t stream) {
    static int grid = 0;
    if (grid == 0) {
        if (n_in != 20 || out_size != T * DM || ws_size < WS_END) { fprintf(stderr, "kernel_launch: unexpected shapes (n_in %d out %d ws %zu)\n", n_in, out_size, ws_size); grid = -1; return; }
        int dev = 0, cus = 0, per_cu = 0;
        (void)hipGetDevice(&dev); (void)hipDeviceGetAttribute(&cus, hipDeviceAttributeMultiprocessorCount, dev);
        (void)hipFuncSetAttribute((const void*)fwd_megakernel, hipFuncAttributeMaxDynamicSharedMemorySize, LDS_BYTES);
        (void)hipOccupancyMaxActiveBlocksPerMultiprocessor(&per_cu, (const void*)fwd_megakernel, 512, LDS_BYTES);
        if (per_cu < 1) { fprintf(stderr, "kernel_launch: occupancy query says %d blocks/CU\n", per_cu); per_cu = 1; }
        (void)hipGetLastError();
        grid = cus * per_cu;
        if (grid != 256) { fprintf(stderr, "kernel_launch: this kernel's unit maps need exactly 256 workgroups (got %d)\n", grid); grid = -1; return; }
    }
    if (grid < 0) return;
    Args a{};
    for (int i = 0; i < 20; ++i) a.in[i] = (const float*)d_in[i];
    a.out_ = (float*)d_out; a.ws_ = (unsigned char*)d_ws;
    void* args[] = {&a};
    hipError_t e = hipLaunchCooperativeKernel((const void*)fwd_megakernel, dim3(grid), dim3(512), args, LDS_BYTES, stream);
    if (e != hipSuccess) fprintf(stderr, "cooperative launch failed: %s (grid %d)\n", hipGetErrorString(e), grid);
}
```

```cpp
#define NPRE_K 2
#include <hip/hip_runtime.h>
#include <hip/hip_cooperative_groups.h>
#include <cstdio>
#include <cstdint>
namespace cg = cooperative_groups;

namespace pg8 {
#define PG8_LAS __attribute__((address_space(3)))
typedef unsigned short bf16_t;
typedef short bf16x8 __attribute__((ext_vector_type(8)));
typedef float f32x4 __attribute__((ext_vector_type(4)));
typedef unsigned u32x4 __attribute__((ext_vector_type(4)));
constexpr int BM = 256, BK = 64, HALF = 128, HTB = HALF * BK * 2  , STAGE_BYTES = 8 * HTB, NXCD = 8, WGM = 8;

__host__ __device__ __forceinline__ int lds_byte(int r, int c) { const int st = (r >> 4) * 2 + (c >> 5), rr = r & 15, cc = c & 31, ob = rr * 64 + cc * 2; return st * 1024 + (ob ^ (((ob >> 9) & 1) << 5)); }
__host__ __device__ __forceinline__ void stage_rc(int b, int& R, int& C) { const int st = b / 1024, sb = b % 1024, swz = sb ^ (((sb >> 9) & 1) << 5); R = (st >> 1) * 16 + swz / 64; C = (st & 1) * 32 + (swz % 64) / 2; }
__host__ __device__ __forceinline__ int perm32(int rho) { const int n = rho >> 4, i = rho & 15; return 8 * (i >> 2) + 4 * n + (i & 3); }

struct Unit { int pm, pn; };
struct Gemm { const bf16_t* A; const bf16_t* Bt; int M, N, K; };

struct StaticOrder {
    int nM, nN, nwg, G, c;
    __host__ __device__ void init_t(int nM_, int nN_, int G_, int c_) { nM = nM_; nN = nN_; nwg = nM * nN; G = G_; c = c_; }
    __host__ __device__ void init(int M, int N, int G_, int c_) { init_t(M / BM, N / BM, G_, c_); }
    __host__ __device__ bool next(int i, Unit& u) const {
        const long L = (long)i * G + c; if (L >= nwg) return false;
        int wgid = (int)L; { const int q = nwg / NXCD, r = nwg % NXCD, xcd = wgid % NXCD, off = wgid / NXCD; wgid = (xcd < r ? xcd * (q + 1) : r * (q + 1) + (xcd - r) * q) + off; }
        const int nig = WGM * nN, gid = wgid / nig, fm = gid * WGM, gsz = (nM - fm) < WGM ? (nM - fm) : WGM;
        u.pm = fm + ((wgid % nig) % gsz); u.pn = (wgid % nig) / gsz; return true;
    }
    __device__ __forceinline__ void a_ready(const Unit&) const {}
    __device__ __forceinline__ void done(const Unit&) const {}
};

__device__ __forceinline__ unsigned cvt_pk_bf16(float lo, float hi) { unsigned r; asm volatile("v_cvt_pk_bf16_f32 %0, %1, %2" : "=v"(r) : "v"(lo), "v"(hi)); return r; }

struct EpiBf16 {
    static constexpr bool PERM = true, AFTER_DRAIN = false, HALO = false;
    bf16_t* O; int ldc; int split_cols; size_t split_stride;
    const float* rowss;
    __device__ __forceinline__ long a_row(int pm) const { return (long)pm * BM; }
    __device__ __forceinline__ void operator()(const f32x4 (&acc)[2][2][4][2], const Unit& u, int wr, int wc, int fr, int fq) const {
        int colt = u.pn * BM; bf16_t* base = O; if (split_cols) { const int t = colt / split_cols; base += (size_t)t * split_stride; colt -= t * split_cols; }
        const int row0 = u.pm * BM + wr * 64 + fr; const int col0 = colt + wc * 32 + 8 * fq;
#pragma unroll
        for (int ai = 0; ai < 2; ++ai)
#pragma unroll
            for (int m = 0; m < 4; ++m) { bf16_t* rowp = base + (size_t)(row0 + ai * HALF + m * 16) * ldc + col0;
                const float rs = rowss ? __builtin_amdgcn_rsqf(rowss[row0 + ai * HALF + m * 16] * (1.0f / 1024.0f) + 1e-6f) : 1.0f;
#pragma unroll
                for (int bj = 0; bj < 2; ++bj) { const f32x4 v0 = acc[ai][bj][m][0] * rs, v1 = acc[ai][bj][m][1] * rs;
                    u32x4 w; w.x = cvt_pk_bf16(v0[0], v0[1]); w.y = cvt_pk_bf16(v0[2], v0[3]); w.z = cvt_pk_bf16(v1[0], v1[1]); w.w = cvt_pk_bf16(v1[2], v1[3]);
                    *(u32x4*)(rowp + bj * HALF) = w; } }
    }
};
template <bool BASEB> struct EpiResT {
    static constexpr bool PERM = true, AFTER_DRAIN = false, HALO = false;
    const float* base0; const float* base1; int split; const bf16_t* baseb; float* out; int ldc; bf16_t* hb; float* rowss;
    __device__ __forceinline__ long a_row(int pm) const { return (long)pm * BM; }
    __device__ __forceinline__ void operator()(const f32x4 (&acc)[2][2][4][2], const Unit& u, int wr, int wc, int fr, int fq) const {
        const int row0 = u.pm * BM + wr * 64 + fr; const int col0 = u.pn * BM + wc * 32 + 8 * fq;
        constexpr int NB = BASEB ? 4 : 2;
#pragma unroll
        for (int ai = 0; ai < 2; ++ai)
#pragma unroll
            for (int mb = 0; mb < 4; mb += NB) {
                f32x4 b0[NB][2], b1[NB][2];
                if (BASEB) { u32x4 w[NB][2];
#pragma unroll
                    for (int q = 0; q < NB; ++q)
#pragma unroll
                        for (int bj = 0; bj < 2; ++bj) w[q][bj] = *(const u32x4*)(baseb + (size_t)(row0 + ai * HALF + (mb + q) * 16) * ldc + col0 + bj * HALF);
#pragma unroll
                    for (int q = 0; q < NB; ++q)
#pragma unroll
                        for (int bj = 0; bj < 2; ++bj) { const u32x4 v = w[q][bj];
                            b0[q][bj] = (f32x4){__uint_as_float(v.x << 16), __uint_as_float(v.x & 0xffff0000u), __uint_as_float(v.y << 16), __uint_as_float(v.y & 0xffff0000u)};
                            b1[q][bj] = (f32x4){__uint_as_float(v.z << 16), __uint_as_float(v.z & 0xffff0000u), __uint_as_float(v.w << 16), __uint_as_float(v.w & 0xffff0000u)}; }
                } else {
#pragma unroll
                    for (int q = 0; q < NB; ++q) { const int row = row0 + ai * HALF + (mb + q) * 16;
                        const float* bp = (row < split ? base0 + (size_t)row * ldc : base1 + (size_t)(row - split) * ldc) + col0;
#pragma unroll
                        for (int bj = 0; bj < 2; ++bj) { b0[q][bj] = *(const f32x4*)(bp + bj * HALF); b1[q][bj] = *(const f32x4*)(bp + bj * HALF + 4); } }
                }
#pragma unroll
                for (int q = 0; q < NB; ++q) { const int m = mb + q; const int row = row0 + ai * HALF + m * 16;
                    float ss = 0.f;
#pragma unroll
                    for (int bj = 0; bj < 2; ++bj) {
                        const f32x4 x0 = acc[ai][bj][m][0] + b0[q][bj], x1 = acc[ai][bj][m][1] + b1[q][bj];
                        if (out) { float* op = out + (size_t)row * ldc + col0 + bj * HALF; *(f32x4*)op = x0; *(f32x4*)(op + 4) = x1; }
                        if (hb) { ss += (x0[0] * x0[0] + x0[1] * x0[1]) + (x0[2] * x0[2] + x0[3] * x0[3]) + (x1[0] * x1[0] + x1[1] * x1[1]) + (x1[2] * x1[2] + x1[3] * x1[3]);
                            u32x4 w; w.x = cvt_pk_bf16(x0[0], x0[1]); w.y = cvt_pk_bf16(x0[2], x0[3]); w.z = cvt_pk_bf16(x1[0], x1[1]); w.w = cvt_pk_bf16(x1[2], x1[3]);
                            *(u32x4*)(hb + (size_t)row * ldc + col0 + bj * HALF) = w; } }
                    if (hb) { ss += __shfl_xor(ss, 16); ss += __shfl_xor(ss, 32); if (fq == 0) atomicAdd(rowss + row, ss); } }
            }
    }
};
__device__ __forceinline__ float dpp_ror1(float v)  { return __builtin_bit_cast(float, __builtin_amdgcn_mov_dpp(__builtin_bit_cast(int, v), 0x121, 0xf, 0xf, true)); }
__device__ __forceinline__ float dpp_ror15(float v) { return __builtin_bit_cast(float, __builtin_amdgcn_mov_dpp(__builtin_bit_cast(int, v), 0x12F, 0xf, 0xf, true)); }
struct EpiGlu {
    static constexpr bool PERM = true, AFTER_DRAIN = false, HALO = true;
    static constexpr int SEQ = 16384, TPS = 67  , FF = 2816;
    bf16_t* O; const float* cw; const float* cb; const float* rowss;
    __device__ __forceinline__ long a_row(int pm) const { const int sq = pm / TPS, tl = pm % TPS; return (long)sq * SEQ + 248 * tl - 1; }
    __device__ __forceinline__ void operator()(const f32x4 (&acc)[2][2][4][2], const Unit& u, int wr, int wc, int fr, int fq) const {
        const int sq = u.pm / TPS, tl = u.pm % TPS; const int f0 = u.pn * 128 + wc * 32 + 8 * fq;
        float w0[8], w1[8], w2[8], bb[8];
#pragma unroll
        for (int j = 0; j < 8; ++j) { constexpr float NL = -1.4426950408889634f;
            w0[j] = NL * cw[f0 + j]; w1[j] = NL * cw[FF + f0 + j]; w2[j] = NL * cw[2 * FF + f0 + j]; bb[j] = NL * cb[f0 + j]; }
        float rsa[2][4];
#pragma unroll
        for (int ai = 0; ai < 2; ++ai)
#pragma unroll
            for (int m = 0; m < 4; ++m) { const int t = 248 * tl - 1 + 62 * (2 * ai + wr) + 4 * fr + m; const bool in = (t >= 0) && (t < SEQ);
                rsa[ai][m] = in ? rowss[(size_t)sq * SEQ + t] : -1.0f; }
#pragma unroll
        for (int ai = 0; ai < 2; ++ai) {
            const int tb = 248 * tl - 1 + 62 * (2 * ai + wr) + 4 * fr;
            float g[4][8], rs[4], rsn[4];
#pragma unroll
            for (int m = 0; m < 4; ++m) {
                rs[m] = (rsa[ai][m] >= 0.f) ? __builtin_amdgcn_rsqf(rsa[ai][m] * (1.0f / 1024.0f) + 1e-6f) : 0.f;
                rsn[m] = rs[m] * -0.6931471805599453f;
#pragma unroll
                for (int j = 0; j < 8; ++j) g[m][j] = acc[ai][0][m][j >> 2][j & 3] * rs[m]; }
            float gl[8], gr[8];
#pragma unroll
            for (int j = 0; j < 8; ++j) { gl[j] = dpp_ror1(g[3][j]); gr[j] = dpp_ror15(g[0][j]); }
#pragma unroll
            for (int m = 0; m < 4; ++m) { const int t = tb + m; const int lr = 4 * fr + m;
                float h[8];
#pragma unroll
                for (int j = 0; j < 8; ++j) {
                    const float gp = (m == 0) ? gl[j] : g[m > 0 ? m - 1 : 0][j];
                    const float gn = (m == 3) ? gr[j] : g[m < 3 ? m + 1 : 3][j];
                    const float y = __builtin_fmaf(w2[j], gn, __builtin_fmaf(w1[j], g[m][j], __builtin_fmaf(w0[j], gp, bb[j])));
                    const float e = __builtin_amdgcn_exp2f(y);
                    h[j] = (y * __builtin_amdgcn_rcpf(1.0f + e)) * (acc[ai][1][m][j >> 2][j & 3] * rsn[m]);
                }
                if (lr >= 1 && lr <= 62 && t >= 0 && t < SEQ) {
                    u32x4 w; w.x = cvt_pk_bf16(h[0], h[1]); w.y = cvt_pk_bf16(h[2], h[3]); w.z = cvt_pk_bf16(h[4], h[5]); w.w = cvt_pk_bf16(h[6], h[7]);
                    *(u32x4*)(O + ((size_t)sq * SEQ + t) * FF + f0) = w; }
            }
        }
    }
};

template <class Epi, class Sched, bool ALIGN_EPI = false, bool SP2 = false>
__device__ __forceinline__ void gemm_phase(PG8_LAS unsigned char* lds, const Gemm g, const Sched& S, const Epi& E, const int wv) {
    int tid_; asm volatile("v_mbcnt_lo_u32_b32 %0, -1, 0\n\tv_mbcnt_hi_u32_b32 %0, -1, %0" : "=v"(tid_)); tid_ += wv * 64;
    const int tid = tid_, wid = __builtin_amdgcn_readfirstlane(tid >> 6), lane = tid & 63, wr = wid >> 2, wc = wid & 3, fr = lane & 15, fq = lane >> 4;
    const int K = g.K, nt = K / BK;
    unsigned voffA[2], voffB[2];
#pragma unroll
    for (int i = 0; i < 2; ++i) { int R, C; stage_rc(tid * 16 + i * 8192, R, C); const int Rb = Epi::PERM ? ((R & ~31) + perm32(R & 31)) : R;
        const int Ra = Epi::HALO ? (62 * (R >> 6) + 4 * (R & 15) + ((R >> 4) & 3)) : R;     voffA[i] = (unsigned)(Ra * K + C) * 2u; voffB[i] = (unsigned)(Rb * K + C) * 2u; }
    const size_t kstep = (size_t)(BK * 2);
    const size_t hstep = (size_t)HALF * K * 2;
    const size_t tstep = 2 * hstep; const size_t hstepA = Epi::HALO ? (size_t)124 * K * 2 : hstep; const size_t rowb = (size_t)K * 2;
    const unsigned ldsw = (unsigned)wid * 1024u;
    const int aoff = lds_byte(wr * 64 + fr, fq * 8), boff = lds_byte(wc * 32 + fr, fq * 8);
#define PG8_SA(b, h) (((b) * 2 + (h)) * HTB)
#define PG8_SB(b, h) ((4 + (b) * 2 + (h)) * HTB)
#define PG8_STAGE(bufoff, gbase, voff) do { _Pragma("unroll") for (int _i = 0; _i < 2; ++_i) \
        __builtin_amdgcn_global_load_lds((const unsigned*)((const char*)(gbase) + (voff)[_i]), (PG8_LAS unsigned*)(lds + (bufoff) + ldsw + _i * 8192), 16, 0, 0); } while (0)
#define PG8_LDA(dst, b, h) do { _Pragma("unroll") for (int m = 0; m < 4; ++m) _Pragma("unroll") for (int k = 0; k < 2; ++k) dst[m][k] = *(const PG8_LAS bf16x8*)(lds + PG8_SA(b, h) + aoff + m * 2048 + k * 1024); } while (0)
#define PG8_LDB(dst, b, h) do { _Pragma("unroll") for (int n = 0; n < 2; ++n) _Pragma("unroll") for (int k = 0; k < 2; ++k) dst[n][k] = *(const PG8_LAS bf16x8*)(lds + PG8_SB(b, h) + boff + n * 2048 + k * 1024); } while (0)
#define PG8_MMA(ai, bj, At, Bt) do { __builtin_amdgcn_s_setprio(1); _Pragma("unroll") for (int m = 0; m < 4; ++m) _Pragma("unroll") for (int n = 0; n < 2; ++n) _Pragma("unroll") for (int k = 0; k < 2; ++k) \
        acc[ai][bj][m][n] = __builtin_amdgcn_mfma_f32_16x16x32_bf16(Bt[n][k], At[m][k], acc[ai][bj][m][n], 0, 0, 0); __builtin_amdgcn_s_setprio(0); } while (0)
#define PG8_WAIT_V(n) asm volatile("s_waitcnt vmcnt(" #n ")" ::: "memory")
#define PG8_WAIT_L(n) asm volatile("s_waitcnt lgkmcnt(" #n ")" ::: "memory")
#define PG8_BAR __builtin_amdgcn_s_barrier()
#define PG8_SCHED __builtin_amdgcn_sched_barrier(0)
    Unit cur, nxt; int ui = 0;
    if (!S.next(0, cur)) return;
    f32x4 acc[2][2][4][2];
#pragma unroll
    for (int a = 0; a < 2; ++a)
#pragma unroll
        for (int b = 0; b < 2; ++b)
#pragma unroll
            for (int m = 0; m < 4; ++m)
#pragma unroll
                for (int n = 0; n < 2; ++n) acc[a][b][m][n] = (f32x4){0.f, 0.f, 0.f, 0.f};
    bf16x8 At[4][2], B0[2][2], B1[2][2];
    const char* cA = (const char*)g.A + (long)E.a_row(cur.pm) * (long)rowb; const char* cB = (const char*)g.Bt + (size_t)cur.pn * tstep;
    S.a_ready(cur);
    if constexpr (SP2) {
        PG8_STAGE(PG8_SB(0, 0), cB, voffB); PG8_STAGE(PG8_SB(0, 1), cB + hstep, voffB); PG8_STAGE(PG8_SA(0, 0), cA, voffA); PG8_STAGE(PG8_SA(0, 1), cA + hstepA, voffA);
        if (wr == 1) PG8_BAR;
        PG8_WAIT_V(2); PG8_BAR;
        PG8_STAGE(PG8_SB(1, 0), cB + kstep, voffB); PG8_STAGE(PG8_SA(1, 0), cA + kstep, voffA); PG8_STAGE(PG8_SB(1, 1), cB + hstep + kstep, voffB);
        PG8_WAIT_V(6); PG8_BAR;
    } else {
        PG8_STAGE(PG8_SB(0, 0), cB, voffB); PG8_STAGE(PG8_SA(0, 0), cA, voffA); PG8_STAGE(PG8_SB(0, 1), cB + hstep, voffB); PG8_STAGE(PG8_SA(0, 1), cA + hstepA, voffA);
        if (wr == 1) PG8_BAR;
        PG8_WAIT_V(4); PG8_BAR;
        PG8_STAGE(PG8_SB(1, 0), cB + kstep, voffB); PG8_STAGE(PG8_SA(1, 0), cA + kstep, voffA); PG8_STAGE(PG8_SB(1, 1), cB + hstep + kstep, voffB);
        PG8_WAIT_V(6); PG8_BAR;
    }
    for (;;) {
        const bool has_next = S.next(ui + 1, nxt);
        const char* nA = has_next ? (const char*)g.A + (long)E.a_row(nxt.pm) * (long)rowb : cA; const char* nB = has_next ? (const char*)g.Bt + (size_t)nxt.pn * tstep : cB;
        for (int t = 0; t < nt; t += 2) {
            const bool last = (t == nt - 2);
            const char* a1 = cA + (size_t)(t + 1) * kstep;
            const char* a2 = last ? nA : cA + (size_t)(t + 2) * kstep; const char* b2 = last ? nB : cB + (size_t)(t + 2) * kstep;
            const char* a3 = a2 + kstep; const char* b3 = b2 + kstep;
            if (last && has_next) S.a_ready(nxt);
            if constexpr (SP2) {
            PG8_LDB(B0, 0, 0); PG8_LDB(B1, 0, 1); PG8_SCHED; PG8_LDA(At, 0, 0); PG8_STAGE(PG8_SA(1, 1), a1 + hstepA, voffA);
            PG8_WAIT_V(8); PG8_WAIT_L(0); PG8_BAR; PG8_MMA(0, 0, At, B0); PG8_MMA(0, 1, At, B1); PG8_BAR; PG8_SCHED;
            PG8_LDA(At, 0, 1); PG8_STAGE(PG8_SB(0, 0), b2, voffB); PG8_STAGE(PG8_SB(0, 1), b2 + hstep, voffB); PG8_STAGE(PG8_SA(0, 0), a2, voffA);
            PG8_WAIT_V(8); PG8_WAIT_L(0); PG8_BAR; PG8_MMA(1, 0, At, B0); PG8_MMA(1, 1, At, B1); PG8_BAR; PG8_SCHED;
            PG8_LDB(B0, 1, 0); PG8_LDB(B1, 1, 1); PG8_SCHED; PG8_LDA(At, 1, 0); PG8_STAGE(PG8_SA(0, 1), a2 + hstepA, voffA);
            PG8_WAIT_V(8); PG8_WAIT_L(0); PG8_BAR; PG8_MMA(0, 0, At, B0); PG8_MMA(0, 1, At, B1); PG8_BAR; PG8_SCHED;
            PG8_LDA(At, 1, 1); PG8_STAGE(PG8_SB(1, 0), b3, voffB); PG8_STAGE(PG8_SB(1, 1), b3 + hstep, voffB); PG8_STAGE(PG8_SA(1, 0), a3, voffA);
            PG8_WAIT_V(8); PG8_WAIT_L(0); PG8_BAR; PG8_MMA(1, 0, At, B0); PG8_MMA(1, 1, At, B1); PG8_BAR; PG8_SCHED;
            } else {
            PG8_LDB(B0, 0, 0); PG8_SCHED; PG8_LDA(At, 0, 0); PG8_STAGE(PG8_SA(1, 1), a1 + hstepA, voffA);
            PG8_WAIT_L(8); PG8_BAR; PG8_WAIT_L(0); PG8_MMA(0, 0, At, B0); PG8_BAR; PG8_SCHED;
            PG8_LDB(B1, 0, 1); PG8_STAGE(PG8_SB(0, 0), b2, voffB);
            PG8_BAR; PG8_WAIT_L(0); PG8_MMA(0, 1, At, B1); PG8_BAR;
            PG8_LDA(At, 0, 1); PG8_STAGE(PG8_SA(0, 0), a2, voffA);
            PG8_BAR; PG8_WAIT_L(0); PG8_MMA(1, 0, At, B0); PG8_BAR; PG8_SCHED;
            PG8_STAGE(PG8_SB(0, 1), b2 + hstep, voffB);
            PG8_WAIT_V(6); PG8_BAR; PG8_MMA(1, 1, At, B1); PG8_BAR;
            PG8_LDB(B0, 1, 0); PG8_SCHED; PG8_LDA(At, 1, 0); PG8_STAGE(PG8_SA(0, 1), a2 + hstepA, voffA);
            PG8_WAIT_L(8); PG8_BAR; PG8_WAIT_L(0); PG8_MMA(0, 0, At, B0); PG8_BAR; PG8_SCHED;
            PG8_LDB(B1, 1, 1); PG8_STAGE(PG8_SB(1, 0), b3, voffB);
            PG8_BAR; PG8_WAIT_L(0); PG8_MMA(0, 1, At, B1); PG8_BAR;
            PG8_LDA(At, 1, 1); PG8_STAGE(PG8_SA(1, 0), a3, voffA);
            PG8_BAR; PG8_WAIT_L(0); PG8_MMA(1, 0, At, B0); PG8_BAR; PG8_SCHED;
            PG8_STAGE(PG8_SB(1, 1), b3 + hstep, voffB);
            PG8_WAIT_V(6); PG8_BAR; PG8_MMA(1, 1, At, B1); PG8_BAR;
            }
        }
        if constexpr (ALIGN_EPI) { if (wr == 0) PG8_BAR; }
        if constexpr (!Epi::AFTER_DRAIN) { E(acc, cur, wr, wc, fr, fq); S.done(cur); }
        if (!has_next) break;
#pragma unroll
        for (int a = 0; a < 2; ++a)
#pragma unroll
            for (int b = 0; b < 2; ++b)
#pragma unroll
                for (int m = 0; m < 4; ++m)
#pragma unroll
                    for (int n = 0; n < 2; ++n) acc[a][b][m][n] = (f32x4){0.f, 0.f, 0.f, 0.f};
        cur = nxt; cA = nA; cB = nB; ++ui;
        if constexpr (ALIGN_EPI) { if (wr == 1) PG8_BAR; }
    }
    PG8_WAIT_V(0);
    if constexpr (!ALIGN_EPI) { if (wr == 0) PG8_BAR; }
    PG8_BAR;
    if constexpr (Epi::AFTER_DRAIN) { E.fused(acc, cur, wr, wc, fr, fq, lds, wid, lane); S.done(cur); }
#undef PG8_SA
#undef PG8_SB
#undef PG8_STAGE
#undef PG8_LDA
#undef PG8_LDB
#undef PG8_MMA
#undef PG8_WAIT_V
#undef PG8_WAIT_L
#undef PG8_BAR
#undef PG8_SCHED
}
}
#define LAS __attribute__((address_space(3)))
typedef unsigned short bf16_t;
typedef short bf16x8 __attribute__((ext_vector_type(8)));
typedef float f32x4 __attribute__((ext_vector_type(4)));
typedef float f32x16 __attribute__((ext_vector_type(16)));
typedef unsigned u32x4 __attribute__((ext_vector_type(4)));
typedef unsigned u32x2 __attribute__((ext_vector_type(2)));
typedef float f32x2_t __attribute__((ext_vector_type(2)));
typedef __bf16 bf16x2_t __attribute__((ext_vector_type(2)));

constexpr int SEQ = 16384, NSEQ = 3, T = NSEQ * SEQ, DM = 1024, FF = 2816;
constexpr float C2_64 = 0.18033688011112042f, C2_96 = 0.14724444602590306f, EPSN = 1e-6f, LOG2E = 1.4426950408889634f;
constexpr int LDS_BYTES = 147456;

__device__ const float INVF_TAB[16] = {1.0f, 0.5623413324356079f, 0.3162277638912201f, 0.17782793939113617f, 0.10000000149011612f, 0.05623413249850273f, 0.03162277489900589f, 0.017782794311642647f,
    0.009999999776482582f, 0.005623413249850273f, 0.003162277629598975f, 0.0017782794311642647f, 0.0010000000474974513f, 0.000562341301701963f, 0.0003162277571391314f, 0.00017782794020604342f};
__device__ __forceinline__ constexpr float invf_c(int i) {
    switch (i) { case 0: return 1.0f; case 1: return 0.5623413324356079f; case 2: return 0.3162277638912201f; case 3: return 0.17782793939113617f; case 4: return 0.10000000149011612f;
        case 5: return 0.05623413249850273f; case 6: return 0.03162277489900589f; case 7: return 0.017782794311642647f; case 8: return 0.009999999776482582f; case 9: return 0.005623413249850273f;
        case 10: return 0.003162277629598975f; case 11: return 0.0017782794311642647f; case 12: return 0.0010000000474974513f; case 13: return 0.000562341301701963f;
        case 14: return 0.0003162277571391314f; default: return 0.00017782794020604342f; }
}
__device__ __forceinline__ float bflo(unsigned w) { return __uint_as_float(w << 16); }
__device__ __forceinline__ float bfhi(unsigned w) { return __uint_as_float(w & 0xffff0000u); }
__device__ __forceinline__ unsigned pk(float lo, float hi) { f32x2_t v = {lo, hi}; bf16x2_t b = __builtin_convertvector(v, bf16x2_t); return __builtin_bit_cast(unsigned, b); }
__device__ __forceinline__ float pairmax(float v) { auto rr = __builtin_amdgcn_permlane32_swap(__float_as_uint(v), __float_as_uint(v), false, false); return fmaxf(__uint_as_float(rr[0]), __uint_as_float(rr[1])); }
__device__ __forceinline__ float pairsum(float v) { auto rr = __builtin_amdgcn_permlane32_swap(__float_as_uint(v), __float_as_uint(v), false, false); return __uint_as_float(rr[0]) + __uint_as_float(rr[1]); }
__device__ __forceinline__ float wave_sum(float v) {
#pragma unroll
    for (int o = 1; o < 64; o <<= 1) v += __shfl_xor(v, o);
    return v;
}
__device__ __forceinline__ void rope_cs(int pos, float invf, float& c, float& s) {
    const float ang = (float)pos * invf;
    const float k = __builtin_rintf(ang * 0.15915494309189535f);
    float r = __builtin_fmaf(-k, 6.2831854820251465f, ang); r = __builtin_fmaf(-k, -1.7484556000744883e-07f, r);
    const float fr = r * 0.15915494309189535f;
    s = __builtin_amdgcn_sinf(fr); c = __builtin_amdgcn_cosf(fr);
}
__device__ __forceinline__ int crow(int r, int hi) { return (r & 3) + 8 * (r >> 2) + 4 * hi; }
#define BAR_LDS() asm volatile("s_waitcnt lgkmcnt(0)\n\ts_barrier" ::: "memory")

struct AttU {
    const bf16_t* q; const bf16_t* k; const bf16_t* kr; const bf16_t* vt; bf16_t* o;
    int kt0, kt1, tq0; const float* gain; float slope2, sink2;
};
template <int MODE> __device__ __forceinline__ void load_q(bf16x8 (&qf)[2][(MODE == 2) ? 6 : 4], const AttU& U, int lane) {
    constexpr int ND = (MODE == 2) ? 6 : 4, QP = 1536;
    const int r32 = lane & 31, hi = lane >> 5;
#pragma unroll
    for (int qb = 0; qb < 2; ++qb) {
        __builtin_amdgcn_sched_barrier(0);
        const bf16_t* src = U.q + (size_t)(32 * qb + r32) * QP + 8 * hi;
        u32x4 raw[ND];
#pragma unroll
        for (int d0 = 0; d0 < ND; ++d0) raw[d0] = *(const u32x4*)(src + 16 * d0);
        int pos = U.tq0 + 32 * qb + r32; asm volatile("" : "+v"(pos));
        if constexpr (MODE == 1) {
#pragma unroll
            for (int d0 = 0; d0 < ND; ++d0) qf[qb][d0] = __builtin_bit_cast(bf16x8, raw[d0]);
        } else if constexpr (MODE == 0) {
            float v[4][8]; float ss = 0.f;
#pragma unroll
            for (int d0 = 0; d0 < 4; ++d0)
#pragma unroll
                for (int j = 0; j < 4; ++j) { const unsigned w = raw[d0][j]; v[d0][2 * j] = bflo(w); v[d0][2 * j + 1] = bfhi(w); ss += v[d0][2 * j] * v[d0][2 * j] + v[d0][2 * j + 1] * v[d0][2 * j + 1]; }
            ss = pairsum(ss);
            const float rstd = rsqrtf(ss * (1.0f / 64.0f) + EPSN) * C2_64;
#pragma unroll
            for (int d0 = 0; d0 < 4; ++d0)
#pragma unroll
                for (int j = 0; j < 8; ++j) v[d0][j] *= rstd * U.gain[16 * d0 + 8 * hi + j];
            const int row = pos >> 6, col = pos & 63;
#pragma unroll
            for (int j = 0; j < 8; ++j) {
                __builtin_amdgcn_sched_barrier(0);
                const float fi = hi ? invf_c(8 + j) : invf_c(j); float c, s;
                rope_cs(row, fi, c, s); { const float x1 = v[0][j], x2 = v[1][j]; v[0][j] = x1 * c - x2 * s; v[1][j] = x2 * c + x1 * s; }
                rope_cs(col, fi, c, s); { const float x1 = v[2][j], x2 = v[3][j]; v[2][j] = x1 * c - x2 * s; v[3][j] = x2 * c + x1 * s; }
            }
#pragma unroll
            for (int d0 = 0; d0 < 4; ++d0) { u32x4 w; w.x = pk(v[d0][0], v[d0][1]); w.y = pk(v[d0][2], v[d0][3]); w.z = pk(v[d0][4], v[d0][5]); w.w = pk(v[d0][6], v[d0][7]); qf[qb][d0] = __builtin_bit_cast(bf16x8, w); }
        } else {
#pragma unroll
            for (int d0 = 0; d0 < 4; ++d0) qf[qb][d0] = __builtin_bit_cast(bf16x8, raw[d0]);
            float a[8], b[8];
#pragma unroll
            for (int j = 0; j < 4; ++j) { a[2 * j] = bflo(raw[ND - 2][j]); a[2 * j + 1] = bfhi(raw[ND - 2][j]); b[2 * j] = bflo(raw[ND - 1][j]); b[2 * j + 1] = bfhi(raw[ND - 1][j]); }
#pragma unroll
            for (int j = 0; j < 8; ++j) { __builtin_amdgcn_sched_barrier(0); const float fi = hi ? invf_c(8 + j) : invf_c(j); float c, s; rope_cs(pos, fi, c, s);
                const float x1 = a[j], x2 = b[j]; a[j] = x1 * c - x2 * s; b[j] = x2 * c + x1 * s; }
            u32x4 wa, wb; wa.x = pk(a[0], a[1]); wa.y = pk(a[2], a[3]); wa.z = pk(a[4], a[5]); wa.w = pk(a[6], a[7]); wb.x = pk(b[0], b[1]); wb.y = pk(b[2], b[3]); wb.z = pk(b[4], b[5]); wb.w = pk(b[6], b[7]);
            qf[qb][ND - 2] = __builtin_bit_cast(bf16x8, wa); qf[qb][ND - 1] = __builtin_bit_cast(bf16x8, wb);
        }
    }
}

__device__ __forceinline__ float fadd_s(float a, float b) { float r; asm("v_add_f32_e32 %0, %1, %2" : "=v"(r) : "v"(a), "v"(b)); return r; }
__device__ __forceinline__ float fsub_s(float a, float b) { float r; asm("v_sub_f32_e32 %0, %1, %2" : "=v"(r) : "v"(a), "v"(b)); return r; }
#define MFMA32(a, b, c) __builtin_amdgcn_mfma_f32_32x32x16_bf16(a, b, c, 0, 0, 0)
#define SBAR() __builtin_amdgcn_sched_barrier(0)
#define MX3(a, b, c) __builtin_fmaxf(__builtin_fmaxf((a), (b)), (c))

template <int MODE, bool FAST> __device__ __forceinline__ bool attn_unit(LAS unsigned char* lds, const AttU& U, const int wv) {
    constexpr int DK = (MODE == 2) ? 96 : 64, ND = DK / 16, KSTR = (MODE == 2) ? 208 : 144, VSTR = 144;
    constexpr int KP = MODE == 0 ? 128 : (MODE == 1 ? 1536 : 1024), VTS = MODE == 2 ? 65536 : 8192;
    constexpr int STG = 64 * KSTR + 64 * VSTR;
    constexpr float THR = 8.0f; constexpr int NPRE = FAST ? NPRE_K : 0;
    int tid_; asm volatile("v_mbcnt_lo_u32_b32 %0, -1, 0\n\tv_mbcnt_hi_u32_b32 %0, -1, %0" : "=v"(tid_)); tid_ += wv * 64;
    const int tid = tid_, lane = tid & 63, r32 = lane & 31, hi = lane >> 5;
    bf16x8 qf[2][ND];
    load_q<MODE>(qf, U, lane);
    f32x16 o[2][2];
#pragma unroll
    for (int a = 0; a < 2; ++a)
#pragma unroll
        for (int b = 0; b < 2; ++b)
#pragma unroll
            for (int r = 0; r < 16; ++r) o[a][b][r] = 0.f;
    float mref[2], lsum[2]; bf16x8 qx[2]; bool bad_ = false;
    const bf16x8 kones = __builtin_bit_cast(bf16x8, (u32x4){hi == 0 ? 0x3f80u : 0u, 0u, 0u, 0u});
    { const unsigned wb0 = (MODE == 1 && !FAST) ? (pk(-U.sink2, 0.f) & 0xffffu) : 0u; const float m0 = -__uint_as_float(wb0 << 16);
      mref[0] = mref[1] = m0; qx[0] = __builtin_bit_cast(bf16x8, (u32x4){hi == 0 ? wb0 : 0u, 0u, 0u, 0u}); qx[1] = qx[0];
      lsum[0] = lsum[1] = (MODE == 1 && hi == 0) ? __builtin_amdgcn_exp2f(U.sink2 - m0) : 0.f; }
    const int krow = tid >> 3, kc = tid & 7;
    const unsigned kgo = (unsigned)(krow * KP + kc * 8) * 2u, krgo = (unsigned)(krow * 32 + kc * 4) * 2u, vgo = (unsigned)tid * 16u;
    const unsigned kdst = krow * KSTR + kc * 16, krdst = krow * KSTR + 128 + kc * 8, vdst = 64 * KSTR + krow * VSTR + kc * 16;
    u32x4 rk, rv, rk2, rv2; u32x2 rr = {0u, 0u}, rr2 = {0u, 0u};
#define ATT_LOADS(RK, RR, RV, tt) do { RK = *(const u32x4*)((const char*)(U.k + (size_t)(tt) * 64 * KP) + kgo); if (MODE == 2) RR = *(const u32x2*)((const char*)(U.kr + (size_t)(tt) * 64 * 32) + krgo); \
        RV = *(const u32x4*)((const char*)(U.vt + (size_t)(tt) * VTS) + vgo); } while (0)
#define ATT_STORES(RK, RR, RV, ss) do { LAS unsigned char* b_ = lds + (ss) * STG; *(LAS u32x4*)(b_ + kdst) = RK; if (MODE == 2) *(LAS u32x2*)(b_ + krdst) = RR; *(LAS u32x4*)(b_ + vdst) = RV; } while (0)
#define ATT_LOAD(tt) ATT_LOADS(rk, rr, rv, tt)
#define ATT_STORE(ss) ATT_STORES(rk, rr, rv, ss)
    const int NT = U.kt1 - U.kt0;
    ATT_LOAD(U.kt0); ATT_STORE(0);
    if (NT > 1) { ATT_LOAD(U.kt0 + 1); ATT_STORE(1); }
    if (NT > 2) ATT_LOAD(U.kt0 + 2);
    if constexpr (FAST) { if (NT > 3) ATT_LOADS(rk2, rr2, rv2, U.kt0 + 3); }
    BAR_LDS();
    f32x16 s[2]; bf16x8 pb[2][2];
    const unsigned koff = r32 * KSTR + hi * 16, voff = 64 * KSTR + r32 * VSTR + hi * 16;
#define ATT_QK(Y, sp, kh) do { LAS const unsigned char* kp_ = lds + (sp) * STG + koff + (kh) * 32 * KSTR; \
        if constexpr (FAST) s[Y] = MFMA32(*(LAS const bf16x8*)(kp_), qf[Y][0], (f32x16){0.f}); \
        else { s[Y] = MFMA32(kones, qx[Y], (f32x16){0.f}); s[Y] = MFMA32(*(LAS const bf16x8*)(kp_), qf[Y][0], s[Y]); } \
        _Pragma("unroll") for (int d0 = 1; d0 < ND; ++d0) s[Y] = MFMA32(*(LAS const bf16x8*)(kp_ + d0 * 32), qf[Y][d0], s[Y]); } while (0)
#define ATT_PV(Y, sp, kh) do { LAS const unsigned char* vp_ = lds + (sp) * STG + voff + (kh) * 64; \
        _Pragma("unroll") for (int db = 0; db < 2; ++db) _Pragma("unroll") for (int ks = 0; ks < 2; ++ks) \
            o[Y][db] = MFMA32(*(LAS const bf16x8*)(vp_ + db * 32 * VSTR + ks * 32), pb[Y][ks], o[Y][db]); } while (0)
#define ATT_ROWMAX(X) float rm_ = MX3(s[X][0], s[X][1], s[X][2]); rm_ = MX3(rm_, s[X][3], s[X][4]); rm_ = MX3(rm_, s[X][5], s[X][6]); rm_ = MX3(rm_, s[X][7], s[X][8]); \
        rm_ = MX3(rm_, s[X][9], s[X][10]); rm_ = MX3(rm_, s[X][11], s[X][12]); rm_ = MX3(rm_, s[X][13], s[X][14]); rm_ = __builtin_fmaxf(rm_, s[X][15]); rm_ = pairmax(rm_)
#define ATT_MF(k_) do { if ((k_) == 0) { if constexpr (!FAST) s[Y_] = MFMA32(kones, qx[Y_], (f32x16){0.f}); } \
        else if ((k_) == 1 && FAST) s[Y_] = MFMA32(kf_[0], qf[Y_][0], (f32x16){0.f}); \
        else if ((k_) <= ND) s[Y_] = MFMA32(kf_[(k_) - 1], qf[Y_][(k_) - 1], s[Y_]); \
        else o[Y_][((k_) - ND - 1) >> 1] = MFMA32(vf_[(k_) - ND - 1], pb[Y_][((k_) - ND - 1) & 1], o[Y_][((k_) - ND - 1) >> 1]); } while (0)
#define ATT_PHASE(X, Y, tx, kh_x, force, sp_v, kh_v, sp_k, kh_k, sp_n, kh_n) do { constexpr int Y_ = (Y); \
        LAS const unsigned char* vp_ = lds + (sp_v) * STG + voff + (kh_v) * 64; LAS const unsigned char* kp_ = lds + (sp_k) * STG + koff + (kh_k) * 32 * KSTR; \
        bf16x8 vf_[4], kf_[ND]; \
        _Pragma("unroll") for (int i_ = 0; i_ < NPRE; ++i_) kf_[i_] = kpre[i_];     \
        _Pragma("unroll") for (int i_ = NPRE; i_ < (ND > 4 ? 3 : ND); ++i_) kf_[i_] = *(LAS const bf16x8*)(kp_ + i_ * 32); \
        if (MODE == 1) { int db_ = U.tq0 + 32 * (X) + r32 - 4 * hi - ((tx) * 64 + (kh_x) * 32); asm volatile("" : "+v"(db_)); \
            _Pragma("unroll") for (int r = 0; r < 16; ++r) { int d = db_ - ((r & 3) + 8 * (r >> 2)); d = d < 0 ? -d : d; s[X][r] = (d <= 128) ? s[X][r] - U.slope2 * (float)d : -INFINITY; } } \
        if (!FAST && (force)) {     \
            ATT_ROWMAX(X); const unsigned wb_ = pk(-(mref[X] + rm_), 0.f) & 0xffffu; \
            const float mn_ = -__uint_as_float(wb_ << 16), dl_ = mn_ - mref[X]; mref[X] = mn_; \
            qx[X] = __builtin_bit_cast(bf16x8, (u32x4){hi == 0 ? wb_ : 0u, 0u, 0u, 0u}); \
            _Pragma("unroll") for (int r = 0; r < 16; ++r) s[X][r] -= dl_; } \
        SBAR(); \
        float ps_ = 0.f; u32x4 w0_, w1_; \
        _Pragma("unroll") for (int g_ = 0; g_ < 8; ++g_) { \
            if (ND > 4 && g_ == 1) { _Pragma("unroll") for (int i_ = 3; i_ < ND; ++i_) kf_[i_] = *(LAS const bf16x8*)(kp_ + i_ * 32); } \
            if (g_ == (ND > 4 ? 4 : 1)) { _Pragma("unroll") for (int i_ = 0; i_ < 4; ++i_) vf_[i_] = *(LAS const bf16x8*)(vp_ + (i_ >> 1) * 32 * VSTR + (i_ & 1) * 32); } \
            ATT_MF(g_); \
            const float a_ = __builtin_amdgcn_exp2f(s[X][2 * g_]), b_ = __builtin_amdgcn_exp2f(s[X][2 * g_ + 1]); \
            ps_ += a_; ps_ += b_; unsigned w_ = pk(a_, b_); asm volatile("" : "+v"(w_), "+v"(ps_)); if (g_ < 4) w0_[g_ & 3] = w_; else w1_[g_ & 3] = w_; \
            SBAR(); } \
        if (NPRE > 0) { LAS const unsigned char* kn_ = lds + (sp_n) * STG + koff + (kh_n) * 32 * KSTR; _Pragma("unroll") for (int i_ = 0; i_ < NPRE; ++i_) kpre[i_] = *(LAS const bf16x8*)(kn_ + i_ * 32); } \
        _Pragma("unroll") for (int k_ = 8; k_ < ND + 5; ++k_) ATT_MF(k_); \
        if constexpr (FAST) { bad_ |= (__builtin_amdgcn_ballot_w64(!(ps_ <= 1.0995116e12f) || ((force) && ps_ < 9.3132257e-10f)) != 0ull); } \
        else if (__builtin_amdgcn_ballot_w64(!(ps_ <= 65536.0f)) != 0ull) {     \
            ATT_ROWMAX(X); const float d_ = fmaxf(rm_, 0.f); const unsigned wb_ = pk(-(mref[X] + d_), 0.f) & 0xffffu; \
            const float mn_ = -__uint_as_float(wb_ << 16), dl_ = mn_ - mref[X]; mref[X] = mn_; \
            qx[X] = __builtin_bit_cast(bf16x8, (u32x4){hi == 0 ? wb_ : 0u, 0u, 0u, 0u}); \
            const float f_ = __builtin_amdgcn_exp2f(-dl_); lsum[X] *= f_; _Pragma("unroll") for (int r = 0; r < 16; ++r) { o[X][0][r] *= f_; o[X][1][r] *= f_; } \
            ps_ = 0.f; \
            _Pragma("unroll") for (int g_ = 0; g_ < 8; ++g_) { s[X][2 * g_] -= dl_; s[X][2 * g_ + 1] -= dl_; \
                const float a_ = __builtin_amdgcn_exp2f(s[X][2 * g_]), b_ = __builtin_amdgcn_exp2f(s[X][2 * g_ + 1]); ps_ += a_; ps_ += b_; \
                const unsigned w_ = pk(a_, b_); if (g_ < 4) w0_[g_ & 3] = w_; else w1_[g_ & 3] = w_; } } \
        lsum[X] += ps_; pb[X][0] = __builtin_bit_cast(bf16x8, w0_); pb[X][1] = __builtin_bit_cast(bf16x8, w1_); SBAR(); } while (0)

    pb[1][0] = (bf16x8){0, 0, 0, 0, 0, 0, 0, 0}; pb[1][1] = pb[1][0];
    ATT_QK(0, 0, 0);
    bf16x8 kpre[NPRE > 0 ? NPRE : 1];
#pragma unroll
    for (int i_ = 0; i_ < NPRE; ++i_) kpre[i_] = *(LAS const bf16x8*)(lds + koff + i_ * 32);
#define ATT_TILE(tt, DIST, RK, RR, RV) do { const int t = (tt); \
        const int j = t - U.kt0, sc = j & 3, sp = (j == 0) ? 0 : ((j + 3) & 3), sn = (j + 1) & 3; \
        if (j + 2 < NT) ATT_STORES(RK, RR, RV, (j + 2) & 3); \
        if (j + (DIST) < NT) ATT_LOADS(RK, RR, RV, t + (DIST)); \
        const bool f0 = (MODE != 1) && (j == 0); \
        ATT_PHASE(0, 1, t, 0, f0, sp, 1, sc, 0, sc, 1); \
        ATT_PHASE(1, 0, t, 0, f0, sc, 0, sc, 1, sc, 1); \
        ATT_PHASE(0, 1, t, 1, false, sc, 0, sc, 1, sn, 0); \
        ATT_PHASE(1, 0, t, 1, false, sc, 1, sn, 0, sn, 0); \
        BAR_LDS(); } while (0)
    if constexpr (FAST) {
        for (int t2 = U.kt0; t2 < U.kt1; t2 += 2) { ATT_TILE(t2, 4, rk, rr, rv); ATT_TILE(t2 + 1, 4, rk2, rr2, rv2); }
    } else {
        for (int t1 = U.kt0; t1 < U.kt1; ++t1) ATT_TILE(t1, 3, rk, rr, rv);
    }
    ATT_PV(1, (NT - 1) & 3, 1);
    BAR_LDS();
#undef ATT_LOAD
#undef ATT_LOADS
#undef ATT_STORES
#undef ATT_TILE
#undef ATT_STORE
#undef ATT_QK
#undef ATT_PV
#undef ATT_PHASE
#undef ATT_MF
#undef ATT_ROWMAX
    if constexpr (FAST) {
        volatile LAS unsigned* vote = (volatile LAS unsigned*)(lds + 131072 + 64);
        if (lane == 0) vote[wv] = bad_ ? 1u : 0u;
        BAR_LDS();
        const unsigned any_ = vote[0] | vote[1] | vote[2] | vote[3] | vote[4] | vote[5] | vote[6] | vote[7];
        BAR_LDS();
        if (any_) return true;
    }
#pragma unroll
    for (int qb = 0; qb < 2; ++qb) {
        const float inv = 1.0f / pairsum(lsum[qb]);
        bf16_t* op = U.o + (size_t)(32 * qb + r32) * DM + 8 * hi;
#pragma unroll
        for (int db = 0; db < 2; ++db)
#pragma unroll
            for (int k = 0; k < 2; ++k) {
                const int ga = 2 * k, gb = 2 * k + 1;
                const unsigned ax = pk(o[qb][db][4 * ga] * inv, o[qb][db][4 * ga + 1] * inv), ay = pk(o[qb][db][4 * ga + 2] * inv, o[qb][db][4 * ga + 3] * inv);
                const unsigned bx = pk(o[qb][db][4 * gb] * inv, o[qb][db][4 * gb + 1] * inv), by = pk(o[qb][db][4 * gb + 2] * inv, o[qb][db][4 * gb + 3] * inv);
                auto rx = __builtin_amdgcn_permlane32_swap(ax, bx, false, false); auto ry = __builtin_amdgcn_permlane32_swap(ay, by, false, false);
                u32x4 w; w.x = rx[0]; w.y = ry[0]; w.z = rx[1]; w.w = ry[1];
                *(u32x4*)(op + 32 * db + 16 * k) = w; }
    }
    return false;
}

__device__ __forceinline__ void rms_row_bf16(const float* xrow, bf16_t* orow, int lane) {
    const f32x4* xr = (const f32x4*)xrow + lane; f32x4 v[4]; float s = 0.f;
#pragma unroll
    for (int j = 0; j < 4; ++j) { v[j] = xr[64 * j]; s += (v[j].x * v[j].x + v[j].y * v[j].y) + (v[j].z * v[j].z + v[j].w * v[j].w); }
    const float rstd = rsqrtf(wave_sum(s) * (1.0f / DM) + EPSN);
    u32x2* o8 = (u32x2*)orow + lane;
#pragma unroll
    for (int j = 0; j < 4; ++j) { u32x2 w; w.x = pk(v[j].x * rstd, v[j].y * rstd); w.y = pk(v[j].z * rstd, v[j].w * rstd); o8[64 * j] = w; }
}
__device__ __forceinline__ void rms_row_final(float* xrow, const float* g, int lane) {
    f32x4* xr = (f32x4*)xrow + lane; const f32x4* gr = (const f32x4*)g + lane; f32x4 v[4]; float s = 0.f;
#pragma unroll
    for (int j = 0; j < 4; ++j) { v[j] = xr[64 * j]; s += (v[j].x * v[j].x + v[j].y * v[j].y) + (v[j].z * v[j].z + v[j].w * v[j].w); }
    const float rstd = rsqrtf(wave_sum(s) * (1.0f / DM) + EPSN);
#pragma unroll
    for (int j = 0; j < 4; ++j) xr[64 * j] = v[j] * rstd * gr[64 * j];
}
struct WDesc { const float* W; int K, Nsrc, Nout; bf16_t* WT; const float* kgain; int mode; };
__device__ __forceinline__ void wprep_item(const WDesc& D, LAS float* scr, int item, int lane) {
    const int nblk = D.Nout / 32, kb = item / nblk, nb = item % nblk, k0 = 64 * kb, n0 = 32 * nb;
    int src0 = n0; float cs = 1.f;
    if (D.mode == 1) { if (n0 >= 768 && n0 < 1280) cs = C2_64; }
    else if (D.mode == 2) { if (n0 >= D.Nsrc) src0 = -1; }
    else if (D.mode == 3) cs = C2_96;
    else if (D.mode == 4) { src0 = (n0 < 1024) ? (n0 >> 6) * 128 + (n0 & 63) : ((n0 - 1024) >> 6) * 128 + 64 + (n0 & 63); }
    else if (D.mode == 5) { const int pn = n0 >> 8, j = n0 & 255; src0 = (j < 128) ? 128 * pn + j : 2816 + 128 * pn + (j - 128); }
#pragma unroll 8
    for (int i = 0; i < 32; ++i) { const int kk = 2 * i + (lane >> 5);
        float v = 0.f; if (src0 >= 0) { v = D.W[(size_t)(k0 + kk) * D.Nsrc + src0 + (lane & 31)] * cs; if (D.kgain) v *= D.kgain[k0 + kk]; }
        scr[kk * 33 + (lane & 31)] = v; }
    asm volatile("s_waitcnt lgkmcnt(0)" ::: "memory");
    const int c = lane & 7;
#pragma unroll
    for (int j = 0; j < 4; ++j) { const int n = (lane >> 3) + 8 * j; const LAS float* s = scr + (8 * c) * 33 + n;
        u32x4 o; o.x = pk(s[0 * 33], s[1 * 33]); o.y = pk(s[2 * 33], s[3 * 33]); o.z = pk(s[4 * 33], s[5 * 33]); o.w = pk(s[6 * 33], s[7 * 33]);
        *(u32x4*)(D.WT + (size_t)(n0 + n) * D.K + k0 + 8 * c) = o; }
    asm volatile("s_waitcnt lgkmcnt(0)" ::: "memory");
}
__device__ __forceinline__ void transpose_store(LAS unsigned char* wl, const u32x4 (&r)[8], bf16_t* dst, int lane) {
#pragma unroll
    for (int c = 0; c < 8; ++c) *(LAS u32x4*)(wl + lane * 144 + 16 * c) = r[c];
    asm volatile("s_waitcnt lgkmcnt(0)" ::: "memory");
    unsigned w[32];
#pragma unroll
    for (int pp = 0; pp < 32; ++pp) {
        const int p0 = 2 * pp, p1 = 2 * pp + 1;
        const int q0 = (p0 & 15) >> 2, q1 = (p1 & 15) >> 2;
        const int t0 = 16 * (p0 >> 4) + 4 * (q0 == 1 ? 2 : (q0 == 2 ? 1 : q0)) + (p0 & 3), t1 = 16 * (p1 >> 4) + 4 * (q1 == 1 ? 2 : (q1 == 2 ? 1 : q1)) + (p1 & 3);
        const unsigned lo = *(LAS const unsigned short*)(wl + t0 * 144 + 2 * lane), hi = *(LAS const unsigned short*)(wl + t1 * 144 + 2 * lane);
        w[pp] = lo | (hi << 16);
    }
#pragma unroll
    for (int c = 0; c < 8; ++c) { u32x4 o; o.x = w[4 * c]; o.y = w[4 * c + 1]; o.z = w[4 * c + 2]; o.w = w[4 * c + 3]; *(u32x4*)(dst + lane * 64 + 8 * c) = o; }
    asm volatile("s_waitcnt lgkmcnt(0)" ::: "memory");
}

#define XB_TMO      128
#define XB_XCNT(j)  (256  + 64 * (j))
#define XB_XSUB(j)  (1280 + 64 * (j))
#define XB_XGEN(j)  (2304 + 64 * (j))
#define XB_TOP      3328
#define XB_TOPGEN   3392
#define XCD_BAR_WORDS 3456
#define XB_SPIN_CAP (1u << 18)

__device__ __forceinline__ unsigned xb_ld(unsigned* p)              { return __hip_atomic_load(p, __ATOMIC_RELAXED, __HIP_MEMORY_SCOPE_AGENT); }
__device__ __forceinline__ unsigned xb_add(unsigned* p, unsigned v) { return __hip_atomic_fetch_add(p, v, __ATOMIC_RELAXED, __HIP_MEMORY_SCOPE_AGENT); }
__device__ __forceinline__ unsigned xb_xcc_id() { return (unsigned)__builtin_amdgcn_s_getreg((3 << 11) | 20) & 0xFu; }
#define XB_SPIN(cond, bar) do { unsigned _sp = 0; while (cond) { __builtin_amdgcn_s_sleep(1); \
    if ((++_sp & 255u) == 0u) { if (xb_ld(&(bar)[XB_TMO])) break; if (_sp > XB_SPIN_CAP) { atomicAdd(&(bar)[XB_TMO], 1u); break; } } } } while (0)

struct XcdBarrier { unsigned* bar; unsigned x; volatile LAS unsigned* st; };
__device__ __forceinline__ void xcd_barrier_complete(unsigned* bar, unsigned x, unsigned& nloc, unsigned& nx) {
    const unsigned G = gridDim.x * gridDim.y * gridDim.z;
    unsigned sum, cnt, mine, sp = 0u;
    for (;;) {
        sum = 0u; cnt = 0u; mine = 0u;
#pragma unroll
        for (unsigned j = 0; j < 16; ++j) { const unsigned c = xb_ld(&bar[XB_XCNT(j)]); sum += c; cnt += (c > 0u) ? 1u : 0u; mine = (j == x) ? c : mine; }
        if (sum == G) break;
        __builtin_amdgcn_s_sleep(1);
        if ((++sp & 255u) == 0u) { if (xb_ld(&bar[XB_TMO])) break; if (sp > XB_SPIN_CAP) { atomicAdd(&bar[XB_TMO], 1u); break; } }
    }
    nloc = mine > 0u ? mine : 1u; nx = cnt > 0u ? cnt : 1u;
}

__device__ __forceinline__ void xcd_barrier(const XcdBarrier& b, const bool is_t0) {
    asm volatile("s_waitcnt vmcnt(0)" ::: "memory");
    __syncthreads();
    if (is_t0) {
        unsigned* bar = b.bar;
        __builtin_amdgcn_s_waitcnt(0);
        unsigned nloc = b.st[0], nx = b.st[1];
        if (nloc == 0u) { xcd_barrier_complete(bar, b.x, nloc, nx); b.st[0] = nloc; b.st[1] = nx; }
        const unsigned old = xb_add(&bar[XB_XSUB(b.x)], 1u);
        const unsigned gen = old / nloc;
        if (old + 1u == (gen + 1u) * nloc) {
            __builtin_amdgcn_fence(__ATOMIC_RELEASE, "agent");
            asm volatile("s_waitcnt vmcnt(0)" ::: "memory");
            const unsigned og = xb_add(&bar[XB_TOP], 1u);
            const unsigned tg = og / nx;
            if (og + 1u == (tg + 1u) * nx) xb_add(&bar[XB_TOPGEN], 1u);
            else XB_SPIN(xb_ld(&bar[XB_TOPGEN]) == tg, bar);
            __builtin_amdgcn_fence(__ATOMIC_ACQUIRE, "agent");
            xb_add(&bar[XB_XGEN(b.x)], 1u);
            asm volatile("s_waitcnt vmcnt(0)" ::: "memory");
        } else {
            XB_SPIN(xb_ld(&bar[XB_XGEN(b.x)]) == gen, bar);
            __builtin_amdgcn_fence(__ATOMIC_ACQUIRE, "agent");
            asm volatile("s_waitcnt vmcnt(0)" ::: "memory");
        }
    }
    __syncthreads();
}

constexpr size_t MiB = 1u << 20;
constexpr size_t WS_WIN0 = 0, WS_WOUT0 = 3 * MiB, WS_WDN = 5 * MiB, WS_WUQ = 7 * MiB, WS_WUKV = 9 * MiB, WS_WOUT1 = 10 * MiB, WS_WUP0 = 12 * MiB, WS_WUP1 = 23 * MiB,
                 WS_WDOWN0 = 34 * MiB, WS_WDOWN1 = 40 * MiB, WS_KROPE = 46 * MiB, WS_BAR = 49 * MiB, WS_ROWSS = 49 * MiB + 65536;
constexpr size_t WS_H = 50 * MiB + 4096;
constexpr size_t WS_CKVN = 50 * MiB + 4096 + 40 * MiB;
constexpr size_t WS_A = 147 * MiB;
constexpr size_t WS_B = 291 * MiB;
constexpr size_t WS_KA = WS_B, WS_VAT = WS_B + 12 * MiB, WS_VBT = WS_B + 24 * MiB;
constexpr size_t WS_KNOPE = WS_B, WS_VRAW = WS_B + 96 * MiB;
constexpr size_t WS_HA = WS_A;
constexpr size_t WS_HID = WS_A + 97 * MiB;
constexpr size_t WS_END = 508 * MiB;

struct Args { const float* in[20]; float* out_; unsigned char* ws_; };
#ifndef PHM
#define PHM 0xFFFFFFFFu
#endif
#define PH(k) ((PHM >> (k)) & 1u)
#ifndef REP_THIN
#define REP_THIN 1
#endif
#ifndef REP_UP
#define REP_UP 1
#endif
#ifndef REP_L0
#define REP_L0 1
#endif
#ifndef REP_MLA
#define REP_MLA 1
#endif

__global__ void __launch_bounds__(512) fwd_megakernel(Args a) {
    extern __shared__ __attribute__((aligned(16))) unsigned char lds_raw[];
    cg::grid_group grid = cg::this_grid();
    LAS unsigned char* lds = (LAS unsigned char*)lds_raw;
    int tid, lane, gw; const __attribute__((address_space(4))) Args* ap;
#define ws (ap->ws_)
#define out (ap->out_)
#define xp (ap->in[0])
#define xs (ap->in[1])
#define Hb ((bf16_t*)(ap->ws_ + WS_H))
#define QKV0 ((bf16_t*)(ap->ws_ + WS_A))
    const int wave = __builtin_amdgcn_readfirstlane(threadIdx.x >> 6);
    const int G = gridDim.x, bx = blockIdx.x, NGW = G * 8;
#define REFRESH() do { asm volatile("v_mbcnt_lo_u32_b32 %0, -1, 0\n\tv_mbcnt_hi_u32_b32 %0, -1, %0" : "=v"(lane)); tid = wave * 64 + lane; gw = bx * 8 + wave; ap = (const __attribute__((address_space(4))) Args*)__builtin_amdgcn_kernarg_segment_ptr(); asm volatile("" : "+s"(ap)); } while (0)
    REFRESH();
    volatile LAS unsigned* xb_st = (volatile LAS unsigned*)(lds + 131072);
    if (threadIdx.x < 2) xb_st[threadIdx.x] = 0u;
    __syncthreads();
#define GRID_BAR() do { REFRESH(); XcdBarrier xb_; xb_.bar = (unsigned*)(ap->ws_ + WS_BAR); xb_.x = xb_xcc_id(); xb_.st = xb_st; xcd_barrier(xb_, tid == 0); REFRESH(); } while (0)
#define xcd_ok (gridDim.x == 256u)
#define xcd ((int)(blockIdx.x & 7u))
#define slot ((int)(blockIdx.x >> 3))

    _Pragma("nounroll") for (int rt_ = 0; rt_ < REP_THIN; ++rt_) if (PH(0)) {
        LAS float* scr = (LAS float*)(lds + wave * 16384);
        WDesc D[10];
        D[0] = WDesc{ap->in[5], 1024, 1536, 1536, (bf16_t*)(ws + WS_WIN0), ap->in[2], 1};
        D[1] = WDesc{ap->in[9], 1024, 1024, 1024, (bf16_t*)(ws + WS_WOUT0), nullptr, 0};
        D[2] = WDesc{ap->in[10], 1024, 672, 768, (bf16_t*)(ws + WS_WDN), ap->in[2] + 1024, 2};
        D[3] = WDesc{ap->in[13], 384, 1536, 1536, (bf16_t*)(ws + WS_WUQ), ap->in[11], 3};
        D[4] = WDesc{ap->in[14], 256, 2048, 2048, (bf16_t*)(ws + WS_WUKV), ap->in[12], 4};
        D[5] = WDesc{ap->in[15], 1024, 1024, 1024, (bf16_t*)(ws + WS_WOUT1), nullptr, 0};
        D[6] = WDesc{ap->in[16], 1024, 5632, 5632, (bf16_t*)(ws + WS_WUP0), ap->in[3], 5};
        D[7] = WDesc{ap->in[16] + (size_t)1024 * 5632, 1024, 5632, 5632, (bf16_t*)(ws + WS_WUP1), ap->in[3] + 1024, 5};
        D[8] = WDesc{ap->in[19], 2816, 1024, 1024, (bf16_t*)(ws + WS_WDOWN0), nullptr, 0};
        D[9] = WDesc{ap->in[19] + (size_t)2816 * 1024, 2816, 1024, 1024, (bf16_t*)(ws + WS_WDOWN1), nullptr, 0};
        int base = 0;
#pragma unroll
        for (int m = 0; m < 10; ++m) {
            const int ni = (D[m].K / 64) * (D[m].Nout / 32);
            int first = gw - (base % NGW); if (first < 0) first += NGW;
            for (int it = first; it < ni; it += NGW) wprep_item(D[m], scr, it, lane);
            base += ni;
        }
        for (int i = bx * 512 + tid; i < 3 * T; i += G * 512) ((float*)(ap->ws_ + WS_ROWSS))[i] = 0.f;
        if (bx == 0) for (int i = tid; i < XCD_BAR_WORDS; i += 512) ((unsigned*)(ap->ws_ + WS_BAR))[i] = 0u;
        for (int m = gw, it_ = 0; it_ < T / 2048; ++it_, m += 2048) rms_row_bf16(m < SEQ ? xp + (size_t)m * DM : xs + (size_t)(m - SEQ) * DM, Hb + (size_t)m * DM, lane);
    }
    grid.sync(); REFRESH();
    if (tid == 0) (void)xb_add(&((unsigned*)(ap->ws_ + WS_BAR))[XB_XCNT(xb_xcc_id())], 1u);

    if (PH(1)) {
        pg8::Gemm g{Hb, (const bf16_t*)(ws + WS_WIN0), T, 1536, 1024}; pg8::StaticOrder S; S.init(T, 1536, G, bx);
        pg8::EpiBf16 E{QKV0, 1536, 0, 0, nullptr};
        pg8::gemm_phase<pg8::EpiBf16, pg8::StaticOrder, true, true>(lds, g, S, E, wave);
    }
    GRID_BAR();
    _Pragma("nounroll") for (int rt_ = 0; rt_ < REP_THIN; ++rt_) if (PH(2)) {
        LAS unsigned char* wl = lds + wave * 9216;
        bf16_t* KA = (bf16_t*)(ws + WS_KA);
        for (int it = gw; it < 768 * 6; it += NGW) {
            const int tl = it / 6, job = it % 6; const int tok = tl * 64 + lane;
            if (job < 4) {
                const int hh = job & 1, isb = job >> 1;
                const bf16_t* src = QKV0 + (size_t)tok * 1536 + (isb ? 1408 : 640) + 64 * hh;
                u32x4 r[8];
#pragma unroll
                for (int c = 0; c < 8; ++c) r[c] = *(const u32x4*)(src + 8 * c);
                bf16_t* dst = (bf16_t*)(ws + (isb ? WS_VBT : WS_VAT)) + ((size_t)tl * 2 + hh) * 4096;
                transpose_store(wl, r, dst, lane);
            } else {
                const int hh = job - 4;
                const bf16_t* src = QKV0 + (size_t)tok * 1536 + 512 + 64 * hh;
                float v[64]; float ss = 0.f;
#pragma unroll
                for (int c = 0; c < 8; ++c) { const u32x4 w = *(const u32x4*)(src + 8 * c);
#pragma unroll
                    for (int j = 0; j < 4; ++j) { v[8 * c + 2 * j] = bflo(w[j]); v[8 * c + 2 * j + 1] = bfhi(w[j]); } }
#pragma unroll
                for (int d = 0; d < 64; ++d) ss += v[d] * v[d];
                const float rstd = rsqrtf(ss * (1.0f / 64.0f) + EPSN);
                const float* kg = ap->in[7];
#pragma unroll
                for (int d = 0; d < 64; ++d) v[d] *= rstd * kg[d];
                int pos = tok & (SEQ - 1); asm volatile("" : "+v"(pos)); const int row = pos >> 6, col = pos & 63;
#pragma unroll
                for (int i = 0; i < 16; ++i) { float c, s;
                    rope_cs(row, invf_c(i), c, s); { const float x1 = v[i], x2 = v[16 + i]; v[i] = x1 * c - x2 * s; v[16 + i] = x2 * c + x1 * s; }
                    rope_cs(col, invf_c(i), c, s); { const float x1 = v[32 + i], x2 = v[48 + i]; v[32 + i] = x1 * c - x2 * s; v[48 + i] = x2 * c + x1 * s; } }
                bf16_t* dst = KA + (size_t)tok * 128 + 64 * hh;
#pragma unroll
                for (int c = 0; c < 8; ++c) { u32x4 w; w.x = pk(v[8 * c], v[8 * c + 1]); w.y = pk(v[8 * c + 2], v[8 * c + 3]); w.z = pk(v[8 * c + 4], v[8 * c + 5]); w.w = pk(v[8 * c + 6], v[8 * c + 7]); *(u32x4*)(dst + 8 * c) = w; }
            }
        }
    }
    GRID_BAR();
    if (PH(3)) {
#define L0_UNITS(CALL0, CALL1) \
        for (int pass = 0; pass < 2; ++pass) \
            for (int i_ = 0; i_ < 3 * REP_L0; ++i_) { const int i = i_ % 3; const unsigned ubit = 1u << (3 * pass + i); \
                const int unit = 96 * xcd + 32 * i + slot; \
                const int combo = unit >> 7, qb = unit & 127, sq = combo >> 1, kvh = combo & 1; \
                const int head = 4 * kvh + (wave >> 1), tq0 = 128 * qb + 64 * (wave & 1); \
                const size_t row0 = (size_t)sq * SEQ; \
                AttU U; \
                U.kr = nullptr; U.gain = ap->in[6]; U.tq0 = tq0; \
                U.o = Hb + (row0 + tq0) * DM + (pass ? 512 : 0) + 64 * head; \
                if (pass == 0) { \
                    U.q = QKV0 + (row0 + tq0) * 1536 + 64 * head; \
                    U.k = (const bf16_t*)(ws + WS_KA) + row0 * 128 + 64 * kvh; \
                    U.vt = (const bf16_t*)(ws + WS_VAT) + ((size_t)sq * 256 * 2 + kvh) * 4096; \
                    U.kt0 = 0; U.kt1 = 256; U.slope2 = 0.f; U.sink2 = 0.f; \
                    if (PH(20)) { CALL0; } \
                } else { \
                    U.q = QKV0 + (row0 + tq0) * 1536 + 768 + 64 * head; \
                    U.k = QKV0 + row0 * 1536 + 1280 + 64 * kvh; \
                    U.vt = (const bf16_t*)(ws + WS_VBT) + ((size_t)sq * 256 * 2 + kvh) * 4096; \
                    U.kt0 = qb > 0 ? 2 * (qb - 1) : 0; U.kt1 = qb < 127 ? 2 * (qb + 2) : 256; \
                    U.slope2 = LOG2E * exp2f(-(float)(head + 1)); U.sink2 = LOG2E * ap->in[8][head]; \
                    if (PH(21)) { CALL1; } \
                } \
            }
        unsigned badmask = 0u;
        L0_UNITS(if ((attn_unit<0, true>(lds, U, wave))) badmask |= ubit, if ((attn_unit<1, true>(lds, U, wave))) badmask |= ubit)
        if (badmask) {
            L0_UNITS(if (badmask & ubit) (void)(attn_unit<0, false>(lds, U, wave)), if (badmask & ubit) (void)(attn_unit<1, false>(lds, U, wave))) }
#undef L0_UNITS
    }
    GRID_BAR();
    if (PH(4)) {
        pg8::Gemm g{Hb, (const bf16_t*)(ws + WS_WOUT0), T, 1024, 1024}; pg8::StaticOrder S; S.init(T, 1024, G, bx);
        pg8::EpiResT<false> E{xp, xs, SEQ, nullptr, nullptr, DM, (bf16_t*)(ws + WS_HA), (float*)(ws + WS_ROWSS)};
        pg8::gemm_phase<pg8::EpiResT<false>, pg8::StaticOrder, true, true>(lds, g, S, E, wave);
    }
    GRID_BAR();

    _Pragma("unroll") for (int layer = 0; layer < 2; ++layer) {
        if (layer == 1) {
            bf16_t* CDOWN = (bf16_t*)(ws + WS_B);
            if (PH(9)) {
                pg8::Gemm g{(const bf16_t*)out  , (const bf16_t*)(ws + WS_WDN), T, 768, 1024}; pg8::StaticOrder S; S.init(T, 768, G, bx);
                pg8::EpiBf16 E{CDOWN, 768, 0, 0, (const float*)(ws + WS_ROWSS) + T};
                pg8::gemm_phase<pg8::EpiBf16, pg8::StaticOrder, true, true>(lds, g, S, E, wave);
            }
            GRID_BAR();
            bf16_t* CQN = Hb; bf16_t* CKVN = (bf16_t*)(ws + WS_CKVN); bf16_t* KROPE = (bf16_t*)(ws + WS_KROPE);
            _Pragma("nounroll") for (int rt_ = 0; rt_ < REP_THIN; ++rt_) if (PH(10)) for (int m = gw, it_ = 0; it_ < T / 2048; ++it_, m += 2048) {
                const bf16_t* row = CDOWN + (size_t)m * 768;
                const unsigned* pq = (const unsigned*)row + 3 * lane; const unsigned* pkv = (const unsigned*)(row + 384) + 2 * lane;
                const unsigned q0 = pq[0], q1 = pq[1], q2 = pq[2], k0 = pkv[0], k1 = pkv[1];
                float sq_ = bflo(q0) * bflo(q0) + bfhi(q0) * bfhi(q0) + bflo(q1) * bflo(q1) + bfhi(q1) * bfhi(q1) + bflo(q2) * bflo(q2) + bfhi(q2) * bfhi(q2);
                float sk_ = bflo(k0) * bflo(k0) + bfhi(k0) * bfhi(k0) + bflo(k1) * bflo(k1) + bfhi(k1) * bfhi(k1);
                const float rq = rsqrtf(wave_sum(sq_) * (1.0f / 384.0f) + EPSN), rk = rsqrtf(wave_sum(sk_) * (1.0f / 256.0f) + EPSN);
                unsigned* oq = (unsigned*)(CQN + (size_t)m * 384) + 3 * lane; unsigned* ok = (unsigned*)(CKVN + (size_t)m * 256) + 2 * lane;
                oq[0] = pk(bflo(q0) * rq, bfhi(q0) * rq); oq[1] = pk(bflo(q1) * rq, bfhi(q1) * rq); oq[2] = pk(bflo(q2) * rq, bfhi(q2) * rq);
                ok[0] = pk(bflo(k0) * rk, bfhi(k0) * rk); ok[1] = pk(bflo(k1) * rk, bfhi(k1) * rk);
                if (lane < 16) { const float x1 = __uint_as_float((unsigned)row[640 + lane] << 16), x2 = __uint_as_float((unsigned)row[656 + lane] << 16);
                    float c, s; rope_cs(m & (SEQ - 1), INVF_TAB[lane], c, s);
                    const unsigned w = pk(x1 * c - x2 * s, x2 * c + x1 * s);
                    KROPE[(size_t)m * 32 + lane] = (bf16_t)(w & 0xffffu); KROPE[(size_t)m * 32 + 16 + lane] = (bf16_t)(w >> 16); }
            }
            GRID_BAR();
            bf16_t* QRAW = (bf16_t*)(ws + WS_A);
            if (PH(11)) {
                { pg8::Gemm g{CQN, (const bf16_t*)(ws + WS_WUQ), T, 1536, 384}; pg8::StaticOrder S; S.init(T, 1536, G, bx);
                  pg8::EpiBf16 E{QRAW, 1536, 0, 0, nullptr};
                  pg8::gemm_phase<pg8::EpiBf16, pg8::StaticOrder, true, true>(lds, g, S, E, wave); }
                { pg8::Gemm g{CKVN, (const bf16_t*)(ws + WS_WUKV), T, 2048, 256}; pg8::StaticOrder S; S.init(T, 2048, G, bx);
                  pg8::EpiBf16 E{(bf16_t*)(ws + WS_KNOPE), 1024, 1024, (WS_VRAW - WS_KNOPE) / 2, nullptr};
                  pg8::gemm_phase<pg8::EpiBf16, pg8::StaticOrder, true, true>(lds, g, S, E, wave); }
            }
            GRID_BAR();
            if (PH(12)) {
                LAS unsigned char* wl = lds + wave * 9216;
                bf16_t* VR = (bf16_t*)(ws + WS_VRAW);
                for (int tl = bx; tl < 768; tl += G) {
                    const bf16_t* src = VR + ((size_t)tl * 64 + lane) * 1024;
                    u32x4 r0[8], r1[8];
#pragma unroll
                    for (int c = 0; c < 8; ++c) { r0[c] = *(const u32x4*)(src + 64 * wave + 8 * c); r1[c] = *(const u32x4*)(src + 64 * (wave + 8) + 8 * c); }
                    asm volatile("s_waitcnt vmcnt(0)" ::: "memory");
                    __syncthreads();
                    transpose_store(wl, r0, VR + ((size_t)tl * 16 + wave) * 4096, lane);
                    transpose_store(wl, r1, VR + ((size_t)tl * 16 + wave + 8) * 4096, lane);
                }
            }
            GRID_BAR();
            if (PH(13)) {
#define L1_UNITS(CALL) \
                for (int i_ = 0; i_ < 6 * REP_MLA; ++i_) { const int i = i_ % 6; const unsigned ubit = 1u << i; \
                    const int combo = xcd * 6 + i, qb = slot; \
                    const int sq = combo >> 4, head = combo & 15, tq0 = 512 * qb + 64 * wave; \
                    const size_t row0 = (size_t)sq * SEQ; \
                    AttU U; \
                    U.q = QRAW + (row0 + tq0) * 1536 + 96 * head; \
                    U.k = (const bf16_t*)(ws + WS_KNOPE) + row0 * 1024 + 64 * head; \
                    U.kr = KROPE + row0 * 32; \
                    U.vt = (const bf16_t*)(ws + WS_VRAW) + ((size_t)sq * 256 * 16 + head) * 4096; \
                    U.o = Hb + (row0 + tq0) * DM + 64 * head; \
                    U.kt0 = 0; U.kt1 = 256; U.tq0 = tq0; U.gain = nullptr; U.slope2 = 0.f; U.sink2 = 0.f; \
                    CALL; \
                }
                unsigned badmask = 0u;
                L1_UNITS(if ((attn_unit<2, true>(lds, U, wave))) badmask |= ubit)
                if (badmask) {
                    L1_UNITS(if (badmask & ubit) (void)(attn_unit<2, false>(lds, U, wave))) }
#undef L1_UNITS
            }
            GRID_BAR();
            if (PH(14)) {
                pg8::Gemm g{Hb, (const bf16_t*)(ws + WS_WOUT1), T, 1024, 1024}; pg8::StaticOrder S; S.init(T, 1024, G, bx);
                pg8::EpiResT<true> E{nullptr, nullptr, 0, (const bf16_t*)out, nullptr, DM, (bf16_t*)(ws + WS_HA), (float*)(ws + WS_ROWSS) + 2 * T};
                pg8::gemm_phase<pg8::EpiResT<true>, pg8::StaticOrder, true, true>(lds, g, S, E, wave);
            }
            GRID_BAR();
        }
        bf16_t* HID = (bf16_t*)(ws + WS_HID);
        _Pragma("nounroll") for (int rep_ = 0; rep_ < REP_UP; ++rep_) if (PH(6)) {
            pg8::Gemm g{(const bf16_t*)(ws + WS_HA), (const bf16_t*)(ws + (layer ? WS_WUP1 : WS_WUP0)), T, 5632, 1024}; pg8::StaticOrder S; S.init_t(3 * pg8::EpiGlu::TPS, 22, G, bx);
            pg8::EpiGlu E{HID, ap->in[17] + (size_t)layer * 3 * FF, ap->in[18] + (size_t)layer * FF, (const float*)(ws + WS_ROWSS) + (size_t)layer * 2 * T};
            pg8::gemm_phase<pg8::EpiGlu, pg8::StaticOrder, true, true>(lds, g, S, E, wave);
        }
        GRID_BAR();
        if (PH(7)) {
            pg8::Gemm g{HID, (const bf16_t*)(ws + (layer ? WS_WDOWN1 : WS_WDOWN0)), T, 1024, 2816}; pg8::StaticOrder S; S.init(T, 1024, G, bx);
            pg8::EpiResT<true> E{nullptr, nullptr, 0, (const bf16_t*)(ws + WS_HA), layer ? out : (float*)nullptr, DM, layer ? (bf16_t*)nullptr : (bf16_t*)out, (float*)(ws + WS_ROWSS) + T};
            pg8::gemm_phase<pg8::EpiResT<true>, pg8::StaticOrder, true, true>(lds, g, S, E, wave);
        }
        GRID_BAR();
    }
    for (int m = gw, it_ = 0; it_ < T / 2048; ++it_, m += 2048) rms_row_final(out + (size_t)m * DM, ap->in[4], lane);
}

#undef ws
#undef out
#undef xp
#undef xs
#undef Hb
#undef QKV0
extern "C" void kernel_launch(void* const* d_in, const int* in_sizes, int n_in, void* d_out, int out_size, void* d_ws, size_t ws_size, hipStream_t stream) {
    static int grid = 0;
    if (grid == 0) {
        if (n_in != 20 || out_size != T * DM || ws_size < WS_END) { fprintf(stderr, "kernel_launch: unexpected shapes (n_in %d out %d ws %zu)\n", n_in, out_size, ws_size); grid = -1; return; }
        int dev = 0, cus = 0, per_cu = 0;
        (void)hipGetDevice(&dev); (void)hipDeviceGetAttribute(&cus, hipDeviceAttributeMultiprocessorCount, dev);
        (void)hipFuncSetAttribute((const void*)fwd_megakernel, hipFuncAttributeMaxDynamicSharedMemorySize, LDS_BYTES);
        (void)hipOccupancyMaxActiveBlocksPerMultiprocessor(&per_cu, (const void*)fwd_megakernel, 512, LDS_BYTES);
        if (per_cu < 1) { fprintf(stderr, "kernel_launch: occupancy query says %d blocks/CU\n", per_cu); per_cu = 1; }
        (void)hipGetLastError();
        grid = cus * per_cu;
        if (grid != 256) { fprintf(stderr, "kernel_launch: this kernel's unit maps need exactly 256 workgroups (got %d)\n", grid); grid = -1; return; }
    }
    if (grid < 0) return;
    Args a{};
    for (int i = 0; i < 20; ++i) a.in[i] = (const float*)d_in[i];
    a.out_ = (float*)d_out; a.ws_ = (unsigned char*)d_ws;
    void* args[] = {&a};
    hipError_t e = hipLaunchCooperativeKernel((const void*)fwd_megakernel, dim3(grid), dim3(512), args, LDS_BYTES, stream);
    if (e != hipSuccess) fprintf(stderr, "cooperative launch failed: %s (grid %d)\n", hipGetErrorString(e), grid);
}
```
